# Optimizing an MI355X kernel written in HIP

```python
import math
import jax, jax.numpy as jnp
from jax import lax
import numpy as np

D_MODEL = 1024
BATCH = 16
SEQ = 2048
DEPTH = 2

D_BRANCH = 512
D_MIX = 3 * D_BRANCH
A_HEADS = 4
A_QK_DIM = 64
A_V_DIM = 2 * A_QK_DIM
A_QK_COLS = A_HEADS * 2 * A_QK_DIM
A_V_COLS = A_HEADS * A_V_DIM
B_HEADS = 4
B_QK_DIM = 64
B_V_DIM = 128
B_QK_COLS = B_HEADS * B_QK_DIM
B_V_COLS = B_HEADS * B_V_DIM
RET_CHUNK = 128
ROPE_BASE = 10000.0
C_GROUPS = 4
C_GROUP_DIM = D_BRANCH // C_GROUPS
POOL_WINDOWS = (2, 4, 8, 16)
NUM_BUCKETS = 32
MAX_DISTANCE = 128
Q_BLOCK = 128
EPS = 1e-6
COLUMN_SIZES = (A_QK_COLS, A_QK_COLS, A_V_COLS, D_BRANCH,
                B_QK_COLS, B_QK_COLS, B_V_COLS, D_BRANCH,
                D_BRANCH, D_BRANCH)
D_IN = 2 * A_QK_COLS + A_V_COLS + 2 * B_QK_COLS + B_V_COLS + 4 * D_BRANCH

kernel_name = "hybrid_diffattn_retention_pool_encoder"


def rmsnorm(x, w):
    xf = x.astype(jnp.float32)
    y = xf * lax.rsqrt(jnp.mean(xf * xf, axis=-1, keepdims=True) + EPS)
    return (y * w.astype(jnp.float32)).astype(x.dtype)


def t5_bucket(rel):
    half = NUM_BUCKETS // 2
    max_exact = half // 2
    ret = jnp.where(rel > 0, half, 0)
    n = jnp.abs(rel)
    nf = jnp.maximum(n, 1).astype(jnp.float32)
    large = max_exact + (jnp.log(nf / max_exact) / math.log(MAX_DISTANCE / max_exact)
                         * (half - max_exact)).astype(jnp.int32)
    large = jnp.minimum(large, half - 1)
    return ret + jnp.where(n < max_exact, n, large)


def diff_attention(q, k, v, rel_bias, lam, lam_init, subln_w):
    B_, S_ = q.shape[0], q.shape[1]
    nb = S_ // Q_BLOCK
    scale = A_QK_DIM ** -0.5
    k_pos = jnp.arange(S_, dtype=jnp.int32)
    qb = q.reshape(B_, nb, Q_BLOCK, A_HEADS, 2, A_QK_DIM).transpose(1, 0, 2, 3, 4, 5)
    bias_table = rel_bias.astype(jnp.float32)

    def block(args):
        q_blk, i = args
        q_pos = i * Q_BLOCK + jnp.arange(Q_BLOCK, dtype=jnp.int32)
        bias = bias_table[t5_bucket(k_pos[None, :] - q_pos[:, None])]
        bias = bias.transpose(2, 0, 1)[None, :, None]
        logits = jnp.einsum('bqhmd,bkhmd->bhmqk', q_blk, k).astype(jnp.float32) * scale + bias
        p = jax.nn.softmax(logits, axis=-1)
        attn = p[:, :, 0] - lam * p[:, :, 1]
        return jnp.einsum('bhqk,bkhd->bqhd', attn.astype(v.dtype), v)

    o = lax.map(block, (qb, jnp.arange(nb, dtype=jnp.int32)))
    o = o.transpose(1, 0, 2, 3, 4).reshape(B_, S_, A_HEADS, A_V_DIM)
    o = rmsnorm(o, subln_w) * (1.0 - lam_init)
    return o.reshape(B_, S_, A_V_COLS)


def rotary(t):
    S_, d = t.shape[1], t.shape[-1]
    half = d // 2
    theta = 1.0 / (ROPE_BASE ** jnp.linspace(0.0, 1.0, half, dtype=jnp.float32))
    ang = jnp.arange(S_, dtype=jnp.float32)[:, None] * theta[None, :]
    cos = jnp.cos(ang)[None, :, None, :]
    sin = jnp.sin(ang)[None, :, None, :]
    t1, t2 = t[..., :half], t[..., half:]
    return jnp.concatenate([t1 * cos - t2 * sin, t1 * sin + t2 * cos], axis=-1)


def retention_dir(q, k, v, log_gamma, strict):
    B_, H, S_, dk = q.shape
    dv = v.shape[-1]
    C = RET_CHUNK
    nc = S_ // C
    idx = jnp.arange(C, dtype=jnp.float32)
    diff = idx[:, None] - idx[None, :]
    mask = (diff > 0) if strict else (diff >= 0)
    decay_intra = jnp.where(mask[None], jnp.exp(log_gamma[:, None, None] * jnp.maximum(diff, 0.0)[None]), 0.0)
    q_dec = jnp.exp(log_gamma[:, None] * (idx + 1.0)[None])[:, :, None]
    k_dec = jnp.exp(log_gamma[:, None] * (C - 1.0 - idx)[None])[:, :, None]
    chunk_dec = jnp.exp(log_gamma * C)[:, None, None]
    qc = q.reshape(B_, H, nc, C, dk).transpose(2, 0, 1, 3, 4)
    kc = k.reshape(B_, H, nc, C, dk).transpose(2, 0, 1, 3, 4)
    vc = v.reshape(B_, H, nc, C, dv).transpose(2, 0, 1, 3, 4)

    def step(R, inp):
        qi, ki, vi = inp
        inner = jnp.einsum('bhnd,bhmd->bhnm', qi, ki) * decay_intra
        out = (jnp.einsum('bhnm,bhmv->bhnv', inner, vi)
               + jnp.einsum('bhnd,bhdv->bhnv', qi * q_dec, R))
        R = R * chunk_dec + jnp.einsum('bhmd,bhmv->bhdv', ki * k_dec, vi)
        return R, out

    R0 = jnp.zeros((B_, H, dk, dv), jnp.float32)
    _, o = lax.scan(step, R0, (qc, kc, vc))
    return o.transpose(1, 2, 0, 3, 4).reshape(B_, H, S_, dv)


def retention(q, k, v, decay_logit):
    B_, S_ = q.shape[0], q.shape[1]
    qf = rotary(q.astype(jnp.float32))
    kf = rotary(k.astype(jnp.float32)) * (B_QK_DIM ** -0.5)
    qf = qf.transpose(0, 2, 1, 3)
    kf = kf.transpose(0, 2, 1, 3)
    vf = v.astype(jnp.float32).transpose(0, 2, 1, 3)
    log_gamma = jax.nn.log_sigmoid(decay_logit.astype(jnp.float32))
    fwd = retention_dir(qf, kf, vf, log_gamma[0], False)
    bwd = retention_dir(jnp.flip(qf, 2), jnp.flip(kf, 2), jnp.flip(vf, 2), log_gamma[1], True)
    o = fwd + jnp.flip(bwd, 2)
    o = o * lax.rsqrt(jnp.mean(o * o, axis=-1, keepdims=True) + EPS)
    return o.transpose(0, 2, 1, 3).reshape(B_, S_, B_V_COLS).astype(v.dtype)


def multiscale_pool(u, pool_w, pool_scale):
    B_, S_ = u.shape[0], u.shape[1]
    uf = u.astype(jnp.float32)
    cs = jnp.concatenate([jnp.zeros_like(uf[:, :1]), jnp.cumsum(uf, axis=1)], axis=1)
    pos = jnp.arange(S_, dtype=jnp.int32)
    outs = []
    for g, w in enumerate(POOL_WINDOWS):
        lo_c, hi_c = g * C_GROUP_DIM, (g + 1) * C_GROUP_DIM
        lo = jnp.clip(pos - w // 2, 0, S_)
        hi = jnp.clip(pos + (w - w // 2), 0, S_)
        window_sum = cs[:, hi, lo_c:hi_c] - cs[:, lo, lo_c:hi_c]
        count = (hi - lo).astype(jnp.float32)[None, :, None]
        outs.append(window_sum / count - uf[:, :, lo_c:hi_c])
    pooled = jnp.stack(outs, axis=2)
    y = jnp.einsum('bsgc,gcd->bsgd', pooled, pool_w.astype(jnp.float32)).reshape(B_, S_, D_BRANCH)
    return (y * pool_scale.astype(jnp.float32)).astype(u.dtype)


def hybrid_layer(x, layer_idx, norm_w, w_in, diff_lambda, diff_subln_w, ret_decay_logit,
                 pool_w, pool_scale, w_out, rel_bias):
    B_, S_ = x.shape[0], x.shape[1]
    h = rmsnorm(x, norm_w)
    proj = jnp.einsum('bsd,de->bse', h, w_in)
    splits = [int(s) for s in np.cumsum(COLUMN_SIZES)[:-1]]
    aq, ak, av, ag, bq, bk, bv, bg, cu, cg = jnp.split(proj, splits, axis=-1)

    lam_init = 0.8 - 0.6 * math.exp(-0.3 * layer_idx)
    lf = diff_lambda.astype(jnp.float32)
    lam = jnp.exp(jnp.sum(lf[0] * lf[1])) - jnp.exp(jnp.sum(lf[2] * lf[3])) + lam_init
    o_a = diff_attention(aq.reshape(B_, S_, A_HEADS, 2, A_QK_DIM),
                         ak.reshape(B_, S_, A_HEADS, 2, A_QK_DIM),
                         av.reshape(B_, S_, A_HEADS, A_V_DIM),
                         rel_bias, lam, lam_init, diff_subln_w)
    o_a = o_a * jax.nn.silu(ag)

    o_b = retention(bq.reshape(B_, S_, B_HEADS, B_QK_DIM),
                    bk.reshape(B_, S_, B_HEADS, B_QK_DIM),
                    bv.reshape(B_, S_, B_HEADS, B_V_DIM),
                    ret_decay_logit)
    o_b = o_b * jax.nn.silu(bg)

    o_c = multiscale_pool(cu, pool_w, pool_scale) * jax.nn.silu(cg)

    mixed = jnp.concatenate([o_a, o_b, o_c], axis=-1)
    return x + jnp.einsum('bse,ed->bsd', mixed, w_out)


def setup_inputs(seed: int = 0) -> dict:
    key = jax.random.key(seed)
    ks = jax.random.split(key, 11)
    x = jax.random.normal(ks[0], (BATCH, SEQ, D_MODEL), jnp.float32)
    norm_w = 1.0 + 0.05 * jax.random.normal(ks[1], (DEPTH, D_MODEL), jnp.float32)
    w_in = jax.random.normal(ks[2], (DEPTH, D_MODEL, D_IN), jnp.float32) * D_MODEL ** -0.5
    diff_lambda = 0.1 * jax.random.normal(ks[3], (DEPTH, 4, A_QK_DIM), jnp.float32)
    diff_subln_w = 1.0 + 0.05 * jax.random.normal(ks[4], (DEPTH, A_V_DIM), jnp.float32)
    e = jnp.stack([5.0 + jnp.arange(B_HEADS, dtype=jnp.float32),
                   5.5 + jnp.arange(B_HEADS, dtype=jnp.float32)])
    ret_decay_logit = (jnp.log(jnp.power(2.0, e) - 1.0)[None]
                       + 0.05 * jax.random.normal(ks[5], (DEPTH, 2, B_HEADS), jnp.float32))
    pool_w = jax.random.normal(ks[6], (DEPTH, C_GROUPS, C_GROUP_DIM, C_GROUP_DIM), jnp.float32) * C_GROUP_DIM ** -0.5
    pool_scale = 0.5 + 0.1 * jax.random.normal(ks[7], (DEPTH, D_BRANCH), jnp.float32)
    w_out = jax.random.normal(ks[8], (DEPTH, D_MIX, D_MODEL), jnp.float32) * D_MIX ** -0.5
    rel_bias = 0.1 * jax.random.normal(ks[9], (NUM_BUCKETS, A_HEADS), jnp.float32)
    final_norm_w = 1.0 + 0.05 * jax.random.normal(ks[10], (D_MODEL,), jnp.float32)
    return {'x': x, 'norm_w': norm_w, 'w_in': w_in, 'diff_lambda': diff_lambda,
            'diff_subln_w': diff_subln_w, 'ret_decay_logit': ret_decay_logit,
            'pool_w': pool_w, 'pool_scale': pool_scale, 'w_out': w_out,
            'rel_bias': rel_bias, 'final_norm_w': final_norm_w}


def reference(x, norm_w, w_in, diff_lambda, diff_subln_w, ret_decay_logit,
              pool_w, pool_scale, w_out, rel_bias, final_norm_w):
    h = x
    for l in range(DEPTH):
        h = hybrid_layer(h, l, norm_w[l], w_in[l], diff_lambda[l], diff_subln_w[l],
                         ret_decay_logit[l], pool_w[l], pool_scale[l], w_out[l], rel_bias)
    return rmsnorm(h, final_norm_w)
```

```cpp
#include <hip/hip_runtime.h>
#include <cstdint>
#include <cstdio>

constexpr int BATCH = 16, SEQ = 2048, DM = 1024, T = BATCH * SEQ;
constexpr int DIN = 4608, DMIX = 1536;
constexpr int C_AQ = 0, C_AK = 512, C_AV = 1024, C_AG = 1536, C_BQ = 2048, C_BK = 2304, C_BV = 2560, C_BG = 3072, C_CU = 3584, C_CG = 4096;
constexpr float EPS = 1e-6f;

typedef unsigned short bf16_t;
__device__ __forceinline__ bf16_t f2bf(float f) { unsigned u = __float_as_uint(f); u += 0x7fffu + ((u >> 16) & 1u); return (bf16_t)(u >> 16); }
__device__ __forceinline__ float bf2f(bf16_t b) { return __uint_as_float(((unsigned)b) << 16); }
__device__ __forceinline__ float bfr(float f) { return bf2f(f2bf(f)); }
__device__ __forceinline__ float silu(float v) { return v / (1.f + __expf(-v)); }

constexpr size_t MiB = 1u << 20;
constexpr size_t WS_BIAS = 1 * MiB;
constexpr size_t WS_RSTD = 2 * MiB;
constexpr size_t WS_PROJ = 96 * MiB;
constexpr size_t WS_MIX = 384 * MiB;

__global__ void k_bias_table(const float* rel_bias, float* tbl) {
    int i = blockIdx.x * blockDim.x + threadIdx.x;
    if (i >= 4096) return;
    int rel = i - 2048;
    int ret = rel > 0 ? 16 : 0;
    int n = rel < 0 ? -rel : rel;
    float nf = (float)(n > 1 ? n : 1);
    float lg = logf(nf / 8.0f) / 2.7725887298583984f * 8.0f;
    int large = 8 + (int)lg;
    if (large > 15) large = 15;
    int b = ret + (n < 8 ? n : large);
    for (int h = 0; h < 4; ++h) tbl[h * 4096 + i] = rel_bias[b * 4 + h];
}

__global__ void k_rstd(const float* x, float* rstd) {
    int row = blockIdx.x * 4 + (threadIdx.x >> 6), lane = threadIdx.x & 63;
    const float4* p = (const float4*)(x + (size_t)row * DM);
    float s = 0.f;
    for (int j = 0; j < 4; ++j) { float4 v = p[lane + 64 * j]; s += v.x * v.x + v.y * v.y + v.z * v.z + v.w * v.w; }
    for (int o = 32; o > 0; o >>= 1) s += __shfl_xor(s, o);
    if (lane == 0) rstd[row] = rsqrtf(s * (1.f / DM) + EPS);
}

template <int MODE>
__global__ void __launch_bounds__(256) k_gemm(const void* Aptr, const float* Bw, const float* rstd, const float* nw, const float* xres, void* Cptr, int M, int N, int K) {
    __shared__ float As[16][65];
    __shared__ float Bs[16][64];
    const int tx = threadIdx.x & 15, ty = threadIdx.x >> 4;
    const int m0 = blockIdx.y * 64, n0 = blockIdx.x * 64;
    float acc[4][4];
    for (int i = 0; i < 4; ++i) for (int j = 0; j < 4; ++j) acc[i][j] = 0.f;
    for (int k0 = 0; k0 < K; k0 += 16) {
        for (int e = threadIdx.x; e < 64 * 16; e += 256) {
            int r = e >> 4, c = e & 15; float v;
            if (MODE == 0) { v = ((const float*)Aptr)[(size_t)(m0 + r) * K + k0 + c]; v = bfr(v * rstd[m0 + r] * nw[k0 + c]); }
            else v = bf2f(((const bf16_t*)Aptr)[(size_t)(m0 + r) * K + k0 + c]);
            As[c][r] = v;
        }
        for (int e = threadIdx.x; e < 16 * 64; e += 256) { int r = e >> 6, c = e & 63; Bs[r][c] = bfr(Bw[(size_t)(k0 + r) * N + n0 + c]); }
        __syncthreads();
#pragma unroll
        for (int kk = 0; kk < 16; ++kk) {
            float a[4], b[4];
#pragma unroll
            for (int i = 0; i < 4; ++i) a[i] = As[kk][ty * 4 + i];
#pragma unroll
            for (int j = 0; j < 4; ++j) b[j] = Bs[kk][tx * 4 + j];
#pragma unroll
            for (int i = 0; i < 4; ++i)
#pragma unroll
                for (int j = 0; j < 4; ++j) acc[i][j] += a[i] * b[j];
        }
        __syncthreads();
    }
    for (int i = 0; i < 4; ++i) for (int j = 0; j < 4; ++j) {
        size_t idx = (size_t)(m0 + ty * 4 + i) * N + n0 + tx * 4 + j;
        if (MODE == 0) ((bf16_t*)Cptr)[idx] = f2bf(acc[i][j]);
        else ((float*)Cptr)[idx] = xres[idx] + acc[i][j];
    }
}

__global__ void k_rotary(bf16_t* proj) {
    size_t i = (size_t)blockIdx.x * blockDim.x + threadIdx.x;
    if (i >= (size_t)T * 256) return;
    int pr = i & 31, h = (i >> 5) & 3, qk = (i >> 7) & 1; size_t t = i >> 8;
    int pos = (int)(t % SEQ);
    float theta = 1.0f / powf(10000.0f, (float)pr / 31.0f);
    float ang = (float)pos * theta;
    float c = cosf(ang), s = sinf(ang);
    bf16_t* p = proj + t * DIN + (qk ? C_BK : C_BQ) + h * 64;
    float t1 = bf2f(p[pr]), t2 = bf2f(p[pr + 32]);
    p[pr] = f2bf(t1 * c - t2 * s); p[pr + 32] = f2bf(t1 * s + t2 * c);
}

__global__ void __launch_bounds__(256) k_diffattn(const bf16_t* proj, const float* biastbl, const float* diff_lambda, const float* subln_w, float lam_init, bf16_t* mixed) {
    __shared__ float Ks[64][64];
    __shared__ float Vs[64][128];
    __shared__ float red[4][64];
    const int tid = threadIdx.x, qi = tid & 63, dq = tid >> 6;
    const int qb = blockIdx.x & 31, h = (blockIdx.x >> 5) & 3, b = blockIdx.x >> 7;
    const int qpos = qb * 64 + qi; const size_t trow = (size_t)b * SEQ + qpos;
    float s01 = 0.f, s23 = 0.f;
    for (int d = 0; d < 64; ++d) { s01 += diff_lambda[d] * diff_lambda[64 + d]; s23 += diff_lambda[128 + d] * diff_lambda[192 + d]; }
    const float lam = expf(s01) - expf(s23) + lam_init;
    const float* btab = biastbl + h * 4096 + 2048 - qpos;
    float res[32];
    for (int mp = 0; mp < 2; ++mp) {
        float q[64];
        const bf16_t* qp = proj + trow * DIN + C_AQ + h * 128 + mp * 64;
#pragma unroll
        for (int d = 0; d < 64; ++d) q[d] = bf2f(qp[d]);
        float o[32];
#pragma unroll
        for (int i = 0; i < 32; ++i) o[i] = 0.f;
        float mx = -1e30f, l = 0.f;
        for (int kt = 0; kt < SEQ / 64; ++kt) {
            __syncthreads();
            for (int e = tid; e < 64 * 64; e += 256) { int r = e >> 6, c = e & 63; Ks[r][c] = bf2f(proj[((size_t)b * SEQ + kt * 64 + r) * DIN + C_AK + h * 128 + mp * 64 + c]); }
            for (int e = tid; e < 64 * 128; e += 256) { int r = e >> 7, c = e & 127; Vs[r][c] = bf2f(proj[((size_t)b * SEQ + kt * 64 + r) * DIN + C_AV + h * 128 + c]); }
            __syncthreads();
            for (int j = 0; j < 64; ++j) {
                float s = 0.f;
#pragma unroll
                for (int d = 0; d < 64; ++d) s += q[d] * Ks[j][d];
                s = s * 0.125f + btab[kt * 64 + j];
                float mn = fmaxf(mx, s); float f = __expf(mx - mn), p = __expf(s - mn);
                l = l * f + p; mx = mn;
#pragma unroll
                for (int i = 0; i < 32; ++i) o[i] = o[i] * f + p * Vs[j][dq * 32 + i];
            }
        }
        const float inv = 1.f / l;
        if (mp == 0) {
#pragma unroll
            for (int i = 0; i < 32; ++i) res[i] = o[i] * inv;
        } else {
#pragma unroll
            for (int i = 0; i < 32; ++i) res[i] -= lam * o[i] * inv;
        }
    }
    float ss = 0.f;
#pragma unroll
    for (int i = 0; i < 32; ++i) ss += res[i] * res[i];
    red[dq][qi] = ss; __syncthreads();
    const float tot = red[0][qi] + red[1][qi] + red[2][qi] + red[3][qi];
    const float rs = rsqrtf(tot * (1.f / 128.f) + EPS) * (1.f - lam_init);
    const bf16_t* gp = proj + trow * DIN + C_AG + h * 128 + dq * 32;
    bf16_t* op = mixed + trow * DMIX + h * 128 + dq * 32;
#pragma unroll
    for (int i = 0; i < 32; ++i) { float g = bf2f(gp[i]); op[i] = f2bf(res[i] * rs * subln_w[dq * 32 + i] * silu(g)); }
}

__global__ void __launch_bounds__(256) k_retention(const bf16_t* proj, const float* decay_logit, bf16_t* mixed) {
    __shared__ float Ks[64][64];
    __shared__ float Vs[64][128];
    __shared__ float red[4][64];
    const int tid = threadIdx.x, qi = tid & 63, dq = tid >> 6;
    const int qb = blockIdx.x & 31, h = (blockIdx.x >> 5) & 3, b = blockIdx.x >> 7;
    const int qpos = qb * 64 + qi; const size_t trow = (size_t)b * SEQ + qpos;
    const float xf = decay_logit[h], xb = decay_logit[4 + h];
    const float lgf = -log1pf(expf(-xf)), lgb = -log1pf(expf(-xb));
    float q[64];
    const bf16_t* qp = proj + trow * DIN + C_BQ + h * 64;
#pragma unroll
    for (int d = 0; d < 64; ++d) q[d] = bf2f(qp[d]);
    float o[32];
#pragma unroll
    for (int i = 0; i < 32; ++i) o[i] = 0.f;
    for (int kt = 0; kt < SEQ / 64; ++kt) {
        __syncthreads();
        for (int e = tid; e < 64 * 64; e += 256) { int r = e >> 6, c = e & 63; Ks[r][c] = bf2f(proj[((size_t)b * SEQ + kt * 64 + r) * DIN + C_BK + h * 64 + c]); }
        for (int e = tid; e < 64 * 128; e += 256) { int r = e >> 7, c = e & 127; Vs[r][c] = bf2f(proj[((size_t)b * SEQ + kt * 64 + r) * DIN + C_BV + h * 128 + c]); }
        __syncthreads();
        for (int j = 0; j < 64; ++j) {
            const int kpos = kt * 64 + j;
            float s = 0.f;
#pragma unroll
            for (int d = 0; d < 64; ++d) s += q[d] * Ks[j][d];
            const float w = (kpos <= qpos) ? expf(lgf * (float)(qpos - kpos)) : expf(lgb * (float)(kpos - qpos));
            const float p = s * 0.125f * w;
#pragma unroll
            for (int i = 0; i < 32; ++i) o[i] += p * Vs[j][dq * 32 + i];
        }
    }
    float ss = 0.f;
#pragma unroll
    for (int i = 0; i < 32; ++i) ss += o[i] * o[i];
    red[dq][qi] = ss; __syncthreads();
    const float tot = red[0][qi] + red[1][qi] + red[2][qi] + red[3][qi];
    const float rs = rsqrtf(tot * (1.f / 128.f) + EPS);
    const bf16_t* gp = proj + trow * DIN + C_BG + h * 128 + dq * 32;
    bf16_t* op = mixed + trow * DMIX + 512 + h * 128 + dq * 32;
#pragma unroll
    for (int i = 0; i < 32; ++i) { float g = bf2f(gp[i]); op[i] = f2bf(o[i] * rs * silu(g)); }
}

__global__ void __launch_bounds__(128) k_pool(const bf16_t* proj, const float* pool_w, const float* pool_scale, bf16_t* mixed) {
    __shared__ float pl[128];
    const int g = blockIdx.x & 3; const size_t t = blockIdx.x >> 2; const int pos = (int)(t % SEQ); const size_t t0 = t - pos;
    const int w = 2 << g, c = threadIdx.x;
    int lo = pos - w / 2; if (lo < 0) lo = 0; int hi = pos + w / 2; if (hi > SEQ) hi = SEQ;
    float s = 0.f;
    for (int p = lo; p < hi; ++p) s += bf2f(proj[(t0 + p) * DIN + C_CU + g * 128 + c]);
    pl[c] = s / (float)(hi - lo) - bf2f(proj[t * DIN + C_CU + g * 128 + c]);
    __syncthreads();
    float y = 0.f;
    for (int k = 0; k < 128; ++k) y += bfr(pl[k]) * bfr(pool_w[(g * 128 + k) * 128 + c]);
    const float gt = bf2f(proj[t * DIN + C_CG + g * 128 + c]);
    mixed[t * DMIX + 1024 + g * 128 + c] = f2bf(y * pool_scale[g * 128 + c] * silu(gt));
}

__global__ void k_final_norm(float* x, const float* w) {
    int row = blockIdx.x * 4 + (threadIdx.x >> 6), lane = threadIdx.x & 63;
    float4* p = (float4*)(x + (size_t)row * DM);
    float4 v[4]; float s = 0.f;
    for (int j = 0; j < 4; ++j) { v[j] = p[lane + 64 * j]; s += v[j].x * v[j].x + v[j].y * v[j].y + v[j].z * v[j].z + v[j].w * v[j].w; }
    for (int o = 32; o > 0; o >>= 1) s += __shfl_xor(s, o);
    const float r = rsqrtf(s * (1.f / DM) + EPS);
    for (int j = 0; j < 4; ++j) { float4 ww = ((const float4*)w)[lane + 64 * j]; float4 o4; o4.x = v[j].x * r * ww.x; o4.y = v[j].y * r * ww.y; o4.z = v[j].z * r * ww.z; o4.w = v[j].w * r * ww.w; p[lane + 64 * j] = o4; }
}

extern "C" void kernel_launch(void* const* d_in, const int* in_sizes, int n_in, void* d_out, int out_size, void* d_ws, size_t ws_size, hipStream_t stream) {
    const float* x = (const float*)d_in[0]; const float* norm_w = (const float*)d_in[1]; const float* w_in = (const float*)d_in[2];
    const float* diff_lambda = (const float*)d_in[3]; const float* subln = (const float*)d_in[4]; const float* decay = (const float*)d_in[5];
    const float* pool_w = (const float*)d_in[6]; const float* pool_scale = (const float*)d_in[7]; const float* w_out = (const float*)d_in[8];
    const float* rel_bias = (const float*)d_in[9]; const float* fnw = (const float*)d_in[10];
    unsigned char* ws = (unsigned char*)d_ws; float* out = (float*)d_out;
    float* biastbl = (float*)(ws + WS_BIAS); float* rstd = (float*)(ws + WS_RSTD);
    bf16_t* proj = (bf16_t*)(ws + WS_PROJ); bf16_t* mixed = (bf16_t*)(ws + WS_MIX);
    k_bias_table<<<16, 256, 0, stream>>>(rel_bias, biastbl);
    for (int l = 0; l < 2; ++l) {
        const float* xin = l == 0 ? x : out;
        const float lam_init = 0.8f - 0.6f * expf(-0.3f * (float)l);
        k_rstd<<<T / 4, 256, 0, stream>>>(xin, rstd);
        k_gemm<0><<<dim3(DIN / 64, T / 64), 256, 0, stream>>>(xin, w_in + (size_t)l * DM * DIN, rstd, norm_w + l * DM, nullptr, proj, T, DIN, DM);
        k_rotary<<<(T * 256) / 256, 256, 0, stream>>>(proj);
        k_diffattn<<<BATCH * 4 * 32, 256, 0, stream>>>(proj, biastbl, diff_lambda + l * 256, subln + l * 128, lam_init, mixed);
        k_retention<<<BATCH * 4 * 32, 256, 0, stream>>>(proj, decay + l * 8, mixed);
        k_pool<<<T * 4, 128, 0, stream>>>(proj, pool_w + (size_t)l * 4 * 128 * 128, pool_scale + l * 512, mixed);
        k_gemm<1><<<dim3(DM / 64, T / 64), 256, 0, stream>>>(mixed, w_out + (size_t)l * DMIX * DM, nullptr, nullptr, xin, out, T, DM, DMIX);
    }
    k_final_norm<<<T / 4, 256, 0, stream>>>(out, fnw);
}
```

```cpp
#include <hip/hip_runtime.h>
#include <hip/hip_cooperative_groups.h>
#include <cstdint>
#include <cstdio>
namespace cg = cooperative_groups;

constexpr int BATCH = 16, SEQ = 2048, DM = 1024, T = BATCH * SEQ;
constexpr int DIN = 4608, DMIX = 1536;
constexpr int C_AQ = 0, C_AK = 512, C_AV = 1024, C_AG = 1536, C_BQ = 2048, C_BK = 2304, C_BV = 2560, C_BG = 3072, C_CU = 3584, C_CG = 4096;
constexpr float EPS = 1e-6f;
constexpr int WGM_P1 = 4;
constexpr int NT = 512;
constexpr int LDS_BYTES = 163840;

typedef unsigned short bf16_t;
__device__ __forceinline__ bf16_t f2bf(float f) { unsigned u = __float_as_uint(f); u += 0x7fffu + ((u >> 16) & 1u); return (bf16_t)(u >> 16); }
__device__ __forceinline__ float bf2f(bf16_t b) { return __uint_as_float(((unsigned)b) << 16); }
__device__ __forceinline__ float bfr(float f) { return bf2f(f2bf(f)); }
__device__ __forceinline__ float silu(float v) { return v * __builtin_amdgcn_rcpf(1.f + __builtin_amdgcn_exp2f(v * -1.4426950408889634f)); }
__device__ __forceinline__ unsigned pk2(float lo, float hi) { return (unsigned)f2bf(lo) | ((unsigned)f2bf(hi) << 16); }

constexpr size_t MiB = 1u << 20;
constexpr size_t WS_CNT = 49152;
constexpr size_t WS_PCNT = 16384;
constexpr size_t WS_SLOT = 1 * MiB + 131072;
constexpr size_t WS_BIAS = 1 * MiB;
constexpr size_t WS_RSS0 = 2 * MiB;
constexpr size_t WS_RSS1 = 2 * MiB + 512 * 1024;
constexpr size_t WS_ROT = 3 * MiB;
constexpr size_t WS_WIN = 4 * MiB;
constexpr size_t WS_WOUT = 22 * MiB;
constexpr size_t WS_XB = 32 * MiB;
constexpr size_t WS_PROJ = 96 * MiB;
constexpr size_t WS_MIX = 384 * MiB;

struct Params {
    const float *x, *norm_w, *w_in, *diff_lambda, *subln, *decay, *pool_w, *pool_scale, *w_out, *rel_bias, *fnw;
    float* out; unsigned char* ws; int use_cg_sync; int pad_;
};
__device__ __forceinline__ void dma16(const void* base, unsigned voff, unsigned ldsaddr) {
    asm volatile("s_mov_b32 m0, %2\n\ts_nop 0\n\tglobal_load_lds_dwordx4 %0, %1" :: "v"(voff), "s"(base), "s"(ldsaddr) : "memory", "m0");
}

#define LAS __attribute__((address_space(3)))
#define XB_TMO      128
#define XB_XCNT(j)  (256  + 64 * (j))
#define XB_XSUB(j)  (1280 + 64 * (j))
#define XB_XGEN(j)  (2304 + 64 * (j))
#define XB_TOP      3328
#define XB_TOPGEN   3392
#define XCD_BAR_WORDS 3456
#define XB_SPIN_CAP (1u << 18)

__device__ __forceinline__ unsigned xb_ld(unsigned* p)              { return __hip_atomic_load(p, __ATOMIC_RELAXED, __HIP_MEMORY_SCOPE_AGENT); }
__device__ __forceinline__ unsigned xb_add(unsigned* p, unsigned v) { return __hip_atomic_fetch_add(p, v, __ATOMIC_RELAXED, __HIP_MEMORY_SCOPE_AGENT); }
__device__ __forceinline__ unsigned xb_xcc_id() { return (unsigned)__builtin_amdgcn_s_getreg((3 << 11) | 20) & 0xFu; }
#define XB_SPIN(cond, bar) do { unsigned _sp = 0; while (cond) { __builtin_amdgcn_s_sleep(1); \
    if ((++_sp & 255u) == 0u) { if (xb_ld(&(bar)[XB_TMO])) break; if (_sp > XB_SPIN_CAP) { atomicAdd(&(bar)[XB_TMO], 1u); break; } } } } while (0)

struct XcdBarrier {
    unsigned* bar; unsigned x;
    volatile LAS unsigned* st;
};

__device__ __forceinline__ XcdBarrier xcd_barrier_post(unsigned* bar, volatile LAS unsigned* st) {
    XcdBarrier b; b.bar = bar; b.x = xb_xcc_id(); b.st = st;
    if (threadIdx.x == 0) (void)xb_add(&bar[XB_XCNT(b.x)], 1u);
    return b;
}
__device__ __forceinline__ void xcd_barrier_complete(unsigned* bar, unsigned x, unsigned& nloc, unsigned& nx) {
    const unsigned G = gridDim.x * gridDim.y * gridDim.z;
    unsigned sum, cnt, mine, sp = 0u;
    for (;;) {
        sum = 0u; cnt = 0u; mine = 0u;
#pragma unroll
        for (unsigned j = 0; j < 16; ++j) { const unsigned c = xb_ld(&bar[XB_XCNT(j)]); sum += c; cnt += (c > 0u) ? 1u : 0u; mine = (j == x) ? c : mine; }
        if (sum == G) break;
        __builtin_amdgcn_s_sleep(1);
        if ((++sp & 255u) == 0u) { if (xb_ld(&bar[XB_TMO])) break; if (sp > XB_SPIN_CAP) { atomicAdd(&bar[XB_TMO], 1u); break; } }
    }
    nloc = mine > 0u ? mine : 1u; nx = cnt > 0u ? cnt : 1u;
}

__device__ __forceinline__ void xcd_barrier(const XcdBarrier& b) {
    asm volatile("s_waitcnt vmcnt(0)" ::: "memory");
    __syncthreads();
    if (threadIdx.x == 0) {
        unsigned* bar = b.bar;
        unsigned bx_ = b.x; asm volatile("" : "+s"(bx_));
        __builtin_amdgcn_s_waitcnt(0);
        unsigned nloc = b.st[0], nx = b.st[1];
        if (nloc == 0u) { xcd_barrier_complete(bar, bx_, nloc, nx); b.st[0] = nloc; b.st[1] = nx; }
        const unsigned old = xb_add(&bar[XB_XSUB(bx_)], 1u);
        const unsigned gen = old / nloc;
        if (old + 1u == (gen + 1u) * nloc) {
            __builtin_amdgcn_fence(__ATOMIC_RELEASE, "agent");
            asm volatile("s_waitcnt vmcnt(0)" ::: "memory");
            const unsigned og = xb_add(&bar[XB_TOP], 1u);
            const unsigned tg = og / nx;
            if (og + 1u == (tg + 1u) * nx) xb_add(&bar[XB_TOPGEN], 1u);
            else XB_SPIN(xb_ld(&bar[XB_TOPGEN]) == tg, bar);
            __builtin_amdgcn_fence(__ATOMIC_ACQUIRE, "agent");
            xb_add(&bar[XB_XGEN(bx_)], 1u);
            asm volatile("s_waitcnt vmcnt(0)" ::: "memory");
        } else {
            XB_SPIN(xb_ld(&bar[XB_XGEN(bx_)]) == gen, bar);
            __builtin_amdgcn_fence(__ATOMIC_ACQUIRE, "agent");
            asm volatile("s_waitcnt vmcnt(0)" ::: "memory");
        }
    }
    __syncthreads();
}

namespace pg8 {
#define PG8_LAS __attribute__((address_space(3)))
typedef unsigned short bf16_t;
typedef short bf16x8 __attribute__((ext_vector_type(8)));
typedef float f32x4 __attribute__((ext_vector_type(4)));
typedef unsigned u32x4 __attribute__((ext_vector_type(4)));
constexpr int BM = 256, BK = 64, HALF = 128, HTB = HALF * BK * 2  , STAGE_BYTES = 8 * HTB, NXCD = 8, WGM = 8;

__host__ __device__ __forceinline__ int lds_byte(int r, int c) { const int st = (r >> 4) * 2 + (c >> 5), rr = r & 15, cc = c & 31, ob = rr * 64 + cc * 2; return st * 1024 + (ob ^ (((ob >> 9) & 1) << 5)); }
__host__ __device__ __forceinline__ void stage_rc(int b, int& R, int& C) { const int st = b / 1024, sb = b % 1024, swz = sb ^ (((sb >> 9) & 1) << 5); R = (st >> 1) * 16 + swz / 64; C = (st & 1) * 32 + (swz % 64) / 2; }
__host__ __device__ __forceinline__ int perm32(int rho) { const int n = rho >> 4, i = rho & 15; return 8 * (i >> 2) + 4 * n + (i & 3); }

struct Unit { int pm, pn; };
struct Gemm { const bf16_t* A; const bf16_t* Bt; int M, N, K; };

struct StaticOrder {
    int nM, nN, nwg, G, c, wgm;
    __host__ __device__ void init(int M, int N, int G_, int c_, int wgm_ = WGM) { nM = M / BM; nN = N / BM; nwg = nM * nN; G = G_; c = c_; wgm = wgm_; }
    __host__ __device__ bool next(int i, Unit& u) const {
        const long L = (long)i * G + c; if (L >= nwg) return false;
        int wgid = (int)L; { const int q = nwg / NXCD, r = nwg % NXCD, xcd = wgid % NXCD, off = wgid / NXCD; wgid = (xcd < r ? xcd * (q + 1) : r * (q + 1) + (xcd - r) * q) + off; }
        const int nig = wgm * nN, gid = wgid / nig, fm = gid * wgm, gsz = (nM - fm) < wgm ? (nM - fm) : wgm;
        u.pm = fm + ((wgid % nig) % gsz); u.pn = (wgid % nig) / gsz; return true;
    }
    __device__ __forceinline__ void a_ready(const Unit&) const {}
    __device__ __forceinline__ void done(const Unit&) const {}
};


__device__ __forceinline__ unsigned cvt_pk_bf16(float lo, float hi) { unsigned r; asm volatile("v_cvt_pk_bf16_f32 %0, %1, %2" : "=v"(r) : "v"(lo), "v"(hi)); return r; }
typedef float f32x2 __attribute__((ext_vector_type(2)));

template <class Epi, class Sched, bool ALIGN_EPI = false, bool SP2 = false>
__device__ __forceinline__ void gemm_phase(PG8_LAS unsigned char* lds, const Gemm g, const Sched& S, const Epi& E) {
    int tid_ = threadIdx.x; asm volatile("" : "+v"(tid_)); const int tid = tid_, wid = __builtin_amdgcn_readfirstlane(tid >> 6), lane = tid & 63, wr = wid >> 2, wc = wid & 3, fr = lane & 15, fq = lane >> 4;
    const int K = g.K, nt = K / BK;
    unsigned voffA[2], voffB[2];
#pragma unroll
    for (int i = 0; i < 2; ++i) { int R, C; stage_rc(tid * 16 + i * 8192, R, C); const int Rb = Epi::PERM ? ((R & ~31) + perm32(R & 31)) : R;
        voffA[i] = (unsigned)(R * K + C) * 2u; voffB[i] = (unsigned)(Rb * K + C) * 2u; }
    const size_t kstep = (size_t)(BK * 2);
    const size_t hstep = (size_t)HALF * K * 2;
    const size_t tstep = 2 * hstep;
    const unsigned ldsw = (unsigned)wid * 1024u;
    const int aoff = lds_byte(wr * 64 + fr, fq * 8), boff = lds_byte(wc * 32 + fr, fq * 8);
#define PG8_SA(b, h) (((b) * 2 + (h)) * HTB)
#define PG8_SB(b, h) ((4 + (b) * 2 + (h)) * HTB)
#define PG8_STAGE(bufoff, gbase, voff) do { _Pragma("unroll") for (int _i = 0; _i < 2; ++_i) \
        dma16((gbase), (voff)[_i], (unsigned)(size_t)(lds + (bufoff) + ldsw + _i * 8192)); } while (0)
#define PG8_LDA(dst, b, h) do { _Pragma("unroll") for (int m = 0; m < 4; ++m) _Pragma("unroll") for (int k = 0; k < 2; ++k) dst[m][k] = *(const PG8_LAS bf16x8*)(lds + PG8_SA(b, h) + aoff + m * 2048 + k * 1024); } while (0)
#define PG8_LDB(dst, b, h) do { _Pragma("unroll") for (int n = 0; n < 2; ++n) _Pragma("unroll") for (int k = 0; k < 2; ++k) dst[n][k] = *(const PG8_LAS bf16x8*)(lds + PG8_SB(b, h) + boff + n * 2048 + k * 1024); } while (0)
#define PG8_MMA(ai, bj, At, Bt) do { __builtin_amdgcn_s_setprio(1); _Pragma("unroll") for (int m = 0; m < 4; ++m) _Pragma("unroll") for (int n = 0; n < 2; ++n) _Pragma("unroll") for (int k = 0; k < 2; ++k) \
        acc[ai][bj][m][n] = __builtin_amdgcn_mfma_f32_16x16x32_bf16(Bt[n][k], At[m][k], acc[ai][bj][m][n], 0, 0, 0); __builtin_amdgcn_s_setprio(0); } while (0)
#define PG8_WAIT_V(n) asm volatile("s_waitcnt vmcnt(" #n ")" ::: "memory")
#define PG8_WAIT_L(n) asm volatile("s_waitcnt lgkmcnt(" #n ")" ::: "memory")
#define PG8_BAR __builtin_amdgcn_s_barrier()
#define PG8_SCHED __builtin_amdgcn_sched_barrier(0)
    Unit cur, nxt; int ui = 0;
    if (!S.next(0, cur)) return;
    f32x4 acc[2][2][4][2];
#pragma unroll
    for (int a = 0; a < 2; ++a)
#pragma unroll
        for (int b = 0; b < 2; ++b)
#pragma unroll
            for (int m = 0; m < 4; ++m)
#pragma unroll
                for (int n = 0; n < 2; ++n) acc[a][b][m][n] = (f32x4){0.f, 0.f, 0.f, 0.f};
    bf16x8 At[4][2], B0[2][2], B1[2][2];
    const char* cA = (const char*)g.A + (size_t)cur.pm * tstep; const char* cB = (const char*)g.Bt + (size_t)cur.pn * tstep;
    S.a_ready(cur);
    if constexpr (SP2) {
        PG8_STAGE(PG8_SB(0, 0), cB, voffB); PG8_STAGE(PG8_SB(0, 1), cB + hstep, voffB); PG8_STAGE(PG8_SA(0, 0), cA, voffA); PG8_STAGE(PG8_SA(0, 1), cA + hstep, voffA);
        if (wr == 1) PG8_BAR;
        PG8_WAIT_V(2); PG8_BAR;
        PG8_STAGE(PG8_SB(1, 0), cB + kstep, voffB); PG8_STAGE(PG8_SA(1, 0), cA + kstep, voffA); PG8_STAGE(PG8_SB(1, 1), cB + hstep + kstep, voffB);
        PG8_WAIT_V(6); PG8_BAR;
    } else {
        PG8_STAGE(PG8_SB(0, 0), cB, voffB); PG8_STAGE(PG8_SA(0, 0), cA, voffA); PG8_STAGE(PG8_SB(0, 1), cB + hstep, voffB); PG8_STAGE(PG8_SA(0, 1), cA + hstep, voffA);
        if (wr == 1) PG8_BAR;
        PG8_WAIT_V(4); PG8_BAR;
        PG8_STAGE(PG8_SB(1, 0), cB + kstep, voffB); PG8_STAGE(PG8_SA(1, 0), cA + kstep, voffA); PG8_STAGE(PG8_SB(1, 1), cB + hstep + kstep, voffB);
        PG8_WAIT_V(6); PG8_BAR;
    }
    for (;;) {
        const bool has_next = S.next(ui + 1, nxt);
        const char* nA = has_next ? (const char*)g.A + (size_t)nxt.pm * tstep : cA; const char* nB = has_next ? (const char*)g.Bt + (size_t)nxt.pn * tstep : cB;
        for (int t = 0; t < nt; t += 2) {
            const bool last = (t == nt - 2);
            const char* a1 = cA + (size_t)(t + 1) * kstep;
            const char* a2 = last ? nA : cA + (size_t)(t + 2) * kstep; const char* b2 = last ? nB : cB + (size_t)(t + 2) * kstep;
            const char* a3 = a2 + kstep; const char* b3 = b2 + kstep;
            if (last && has_next) S.a_ready(nxt);
            if constexpr (SP2) {
            PG8_LDB(B0, 0, 0); PG8_LDB(B1, 0, 1); PG8_SCHED; PG8_LDA(At, 0, 0); PG8_STAGE(PG8_SA(1, 1), a1 + hstep, voffA);
            PG8_WAIT_V(8); PG8_WAIT_L(0); PG8_BAR; PG8_MMA(0, 0, At, B0); PG8_MMA(0, 1, At, B1); PG8_BAR; PG8_SCHED;
            PG8_LDA(At, 0, 1); PG8_STAGE(PG8_SB(0, 0), b2, voffB); PG8_STAGE(PG8_SB(0, 1), b2 + hstep, voffB); PG8_STAGE(PG8_SA(0, 0), a2, voffA);
            PG8_WAIT_V(8); PG8_WAIT_L(0); PG8_BAR; PG8_MMA(1, 0, At, B0); PG8_MMA(1, 1, At, B1); PG8_BAR; PG8_SCHED;
            PG8_LDB(B0, 1, 0); PG8_LDB(B1, 1, 1); PG8_SCHED; PG8_LDA(At, 1, 0); PG8_STAGE(PG8_SA(0, 1), a2 + hstep, voffA);
            PG8_WAIT_V(8); PG8_WAIT_L(0); PG8_BAR; PG8_MMA(0, 0, At, B0); PG8_MMA(0, 1, At, B1); PG8_BAR; PG8_SCHED;
            PG8_LDA(At, 1, 1); PG8_STAGE(PG8_SB(1, 0), b3, voffB); PG8_STAGE(PG8_SB(1, 1), b3 + hstep, voffB); PG8_STAGE(PG8_SA(1, 0), a3, voffA);
            PG8_WAIT_V(8); PG8_WAIT_L(0); PG8_BAR; PG8_MMA(1, 0, At, B0); PG8_MMA(1, 1, At, B1); PG8_BAR; PG8_SCHED;
            } else {
            PG8_LDB(B0, 0, 0); PG8_SCHED; PG8_LDA(At, 0, 0); PG8_STAGE(PG8_SA(1, 1), a1 + hstep, voffA);
            PG8_WAIT_L(8); PG8_BAR; PG8_WAIT_L(0); PG8_MMA(0, 0, At, B0); PG8_BAR; PG8_SCHED;
            PG8_LDB(B1, 0, 1); PG8_STAGE(PG8_SB(0, 0), b2, voffB);
            PG8_BAR; PG8_WAIT_L(0); PG8_MMA(0, 1, At, B1); PG8_BAR;
            PG8_LDA(At, 0, 1); PG8_STAGE(PG8_SA(0, 0), a2, voffA);
            PG8_BAR; PG8_WAIT_L(0); PG8_MMA(1, 0, At, B0); PG8_BAR; PG8_SCHED;
            PG8_STAGE(PG8_SB(0, 1), b2 + hstep, voffB);
            PG8_WAIT_V(6); PG8_BAR; PG8_MMA(1, 1, At, B1); PG8_BAR;
            PG8_LDB(B0, 1, 0); PG8_SCHED; PG8_LDA(At, 1, 0); PG8_STAGE(PG8_SA(0, 1), a2 + hstep, voffA);
            PG8_WAIT_L(8); PG8_BAR; PG8_WAIT_L(0); PG8_MMA(0, 0, At, B0); PG8_BAR; PG8_SCHED;
            PG8_LDB(B1, 1, 1); PG8_STAGE(PG8_SB(1, 0), b3, voffB);
            PG8_BAR; PG8_WAIT_L(0); PG8_MMA(0, 1, At, B1); PG8_BAR;
            PG8_LDA(At, 1, 1); PG8_STAGE(PG8_SA(1, 0), a3, voffA);
            PG8_BAR; PG8_WAIT_L(0); PG8_MMA(1, 0, At, B0); PG8_BAR; PG8_SCHED;
            PG8_STAGE(PG8_SB(1, 1), b3 + hstep, voffB);
            PG8_WAIT_V(6); PG8_BAR; PG8_MMA(1, 1, At, B1); PG8_BAR;
            }
        }
        if constexpr (ALIGN_EPI) { if (wr == 0) PG8_BAR; }
        if constexpr (!Epi::AFTER_DRAIN) { E(acc, cur, wr, wc, fr, fq); S.done(cur); }
        if (!has_next) break;
#pragma unroll
        for (int a = 0; a < 2; ++a)
#pragma unroll
            for (int b = 0; b < 2; ++b)
#pragma unroll
                for (int m = 0; m < 4; ++m)
#pragma unroll
                    for (int n = 0; n < 2; ++n) acc[a][b][m][n] = (f32x4){0.f, 0.f, 0.f, 0.f};
        cur = nxt; cA = nA; cB = nB; ++ui;
        if constexpr (ALIGN_EPI) { if (wr == 1) PG8_BAR; }
    }
    PG8_WAIT_V(0);
    if constexpr (!ALIGN_EPI) { if (wr == 0) PG8_BAR; }
    PG8_BAR;
    if constexpr (Epi::AFTER_DRAIN) { E.fused(acc, cur, wr, wc, fr, fq, lds, wid, lane); S.done(cur); }
#undef PG8_SA
#undef PG8_SB
#undef PG8_STAGE
#undef PG8_LDA
#undef PG8_LDB
#undef PG8_MMA
#undef PG8_WAIT_V
#undef PG8_WAIT_L
#undef PG8_BAR
#undef PG8_SCHED
}
}

template <int LD> __device__ __forceinline__ void epi_put16(const pg8::u32x4& wa, const pg8::u32x4& wb, bf16_t* gbase, PG8_LAS unsigned char* sc, int fr, int fq, int lane) {
    *(PG8_LAS pg8::u32x4*)(sc + fr * 128 + ((fq ^ (fr & 7)) * 16)) = wa;
    *(PG8_LAS pg8::u32x4*)(sc + fr * 128 + (((4 + fq) ^ (fr & 7)) * 16)) = wb;
    asm volatile("s_waitcnt lgkmcnt(0)" ::: "memory");
    const int rr = lane >> 3, c = lane & 7;
    const pg8::u32x4 x0 = *(const PG8_LAS pg8::u32x4*)(sc + rr * 128 + ((c ^ (rr & 7)) * 16)), x1 = *(const PG8_LAS pg8::u32x4*)(sc + (rr + 8) * 128 + ((c ^ (rr & 7)) * 16));
    asm volatile("s_waitcnt lgkmcnt(0)" ::: "memory");
    *(pg8::u32x4*)(gbase + (size_t)rr * LD + c * 8) = x0; *(pg8::u32x4*)(gbase + (size_t)(rr + 8) * LD + c * 8) = x1;
}
__device__ __forceinline__ void epi_put32(const pg8::f32x4& va, const pg8::f32x4& vb, float* gbase, PG8_LAS unsigned char* sc, int fr, int fq, int lane) {
    *(PG8_LAS pg8::f32x4*)(sc + fr * 128 + (((2 * fq) ^ (fr & 7)) * 16)) = va;
    *(PG8_LAS pg8::f32x4*)(sc + fr * 128 + (((2 * fq + 1) ^ (fr & 7)) * 16)) = vb;
    asm volatile("s_waitcnt lgkmcnt(0)" ::: "memory");
    const int rr = lane >> 3, c = lane & 7;
    const pg8::f32x4 x0 = *(const PG8_LAS pg8::f32x4*)(sc + rr * 128 + ((c ^ (rr & 7)) * 16)), x1 = *(const PG8_LAS pg8::f32x4*)(sc + (rr + 8) * 128 + ((c ^ (rr & 7)) * 16));
    asm volatile("s_waitcnt lgkmcnt(0)" ::: "memory");
    *(pg8::f32x4*)(gbase + (size_t)rr * DM + c * 4) = x0; *(pg8::f32x4*)(gbase + (size_t)(rr + 8) * DM + c * 4) = x1;
}
struct EpiProj {
    static constexpr bool PERM = true, AFTER_DRAIN = false;
    bf16_t* O; const float* rowss; const float2* rot; PG8_LAS unsigned char* xs;
    __device__ __forceinline__ void operator()(const pg8::f32x4 (&acc)[2][2][4][2], const pg8::Unit& u, int wr, int wc, int fr, int fq) const {
        const int lane = fq * 16 + fr;
        PG8_LAS unsigned char* sc = xs + (wr * 4 + wc) * 2048;
        const int rowb = u.pm * 256 + wr * 64, colb = u.pn * 256 + wc * 64;
        const bool rotary = (u.pn == 8 || u.pn == 9);
        const bool gatep = (u.pn == 6 || u.pn == 7 || u.pn == 12 || u.pn == 13 || u.pn == 16 || u.pn == 17);
        float rsv[8];
#pragma unroll
        for (int i = 0; i < 8; ++i) rsv[i] = rowss[rowb + (i >> 2) * 128 + (i & 3) * 16 + fr];
#pragma unroll
        for (int ai = 0; ai < 2; ++ai)
#pragma unroll
            for (int m = 0; m < 4; ++m) {
                const int row = rowb + ai * 128 + m * 16 + fr;
                const float rs = rsqrtf(rsv[ai * 4 + m] * (1.f / DM) + EPS);
                pg8::f32x4 a0 = acc[ai][0][m][0] * rs, a1 = acc[ai][0][m][1] * rs, b0 = acc[ai][1][m][0] * rs, b1 = acc[ai][1][m][1] * rs;
                if (gatep) {
#pragma unroll
                    for (int j = 0; j < 4; ++j) { a0[j] = silu(a0[j]); a1[j] = silu(a1[j]); b0[j] = silu(b0[j]); b1[j] = silu(b1[j]); }
                }
                pg8::u32x4 w1, w2;
                if (rotary) {
                    const pg8::f32x4* cs = (const pg8::f32x4*)(rot + (size_t)(row & (SEQ - 1)) * 32 + 8 * fq);
                    const pg8::f32x4 c01 = cs[0], c23 = cs[1], c45 = cs[2], c67 = cs[3];
                    w1.x = pg8::cvt_pk_bf16(a0[0] * c01[0] - b0[0] * c01[1], a0[1] * c01[2] - b0[1] * c01[3]); w2.x = pg8::cvt_pk_bf16(a0[0] * c01[1] + b0[0] * c01[0], a0[1] * c01[3] + b0[1] * c01[2]);
                    w1.y = pg8::cvt_pk_bf16(a0[2] * c23[0] - b0[2] * c23[1], a0[3] * c23[2] - b0[3] * c23[3]); w2.y = pg8::cvt_pk_bf16(a0[2] * c23[1] + b0[2] * c23[0], a0[3] * c23[3] + b0[3] * c23[2]);
                    w1.z = pg8::cvt_pk_bf16(a1[0] * c45[0] - b1[0] * c45[1], a1[1] * c45[2] - b1[1] * c45[3]); w2.z = pg8::cvt_pk_bf16(a1[0] * c45[1] + b1[0] * c45[0], a1[1] * c45[3] + b1[1] * c45[2]);
                    w1.w = pg8::cvt_pk_bf16(a1[2] * c67[0] - b1[2] * c67[1], a1[3] * c67[2] - b1[3] * c67[3]); w2.w = pg8::cvt_pk_bf16(a1[2] * c67[1] + b1[2] * c67[0], a1[3] * c67[3] + b1[3] * c67[2]);
                } else {
                    w1.x = pg8::cvt_pk_bf16(a0[0], a0[1]); w1.y = pg8::cvt_pk_bf16(a0[2], a0[3]); w1.z = pg8::cvt_pk_bf16(a1[0], a1[1]); w1.w = pg8::cvt_pk_bf16(a1[2], a1[3]);
                    w2.x = pg8::cvt_pk_bf16(b0[0], b0[1]); w2.y = pg8::cvt_pk_bf16(b0[2], b0[3]); w2.z = pg8::cvt_pk_bf16(b1[0], b1[1]); w2.w = pg8::cvt_pk_bf16(b1[2], b1[3]);
                }
                epi_put16<DIN>(w1, w2, O + (size_t)(rowb + ai * 128 + m * 16) * DIN + colb, sc, fr, fq, lane);
            }
    }
};
template <int MODE> struct EpiOut {
    static constexpr bool PERM = true, AFTER_DRAIN = false;
    float* out; bf16_t* xb; float* rss; PG8_LAS unsigned char* xs;
    __device__ __forceinline__ void operator()(const pg8::f32x4 (&acc)[2][2][4][2], const pg8::Unit& u, int wr, int wc, int fr, int fq) const {
        const int lane = fq * 16 + fr;
        PG8_LAS unsigned char* sc = xs + (wr * 4 + wc) * 2048;
        const int rowb = u.pm * 256 + wr * 64, colb = u.pn * 256 + wc * 64;
        pg8::u32x4 xrv[8][2];
#pragma unroll
        for (int i = 0; i < 8; ++i)
#pragma unroll
            for (int bj = 0; bj < 2; ++bj) xrv[i][bj] = *(const pg8::u32x4*)(xb + (size_t)(rowb + (i >> 2) * 128 + (i & 3) * 16 + fr) * DM + colb + 8 * fq + bj * 32);
#pragma unroll
        for (int ai = 0; ai < 2; ++ai)
#pragma unroll
            for (int m = 0; m < 4; ++m) {
                const int row = rowb + ai * 128 + m * 16 + fr;
                float ss = 0.f; pg8::u32x4 w[2]; pg8::f32x4 v[2][2];
#pragma unroll
                for (int bj = 0; bj < 2; ++bj) {
                    const pg8::u32x4 xr = xrv[ai * 4 + m][bj];
                    pg8::f32x4 v0 = acc[ai][bj][m][0], v1 = acc[ai][bj][m][1];
                    v0[0] += __uint_as_float(xr.x << 16); v0[1] += __uint_as_float(xr.x & 0xffff0000u); v0[2] += __uint_as_float(xr.y << 16); v0[3] += __uint_as_float(xr.y & 0xffff0000u);
                    v1[0] += __uint_as_float(xr.z << 16); v1[1] += __uint_as_float(xr.z & 0xffff0000u); v1[2] += __uint_as_float(xr.w << 16); v1[3] += __uint_as_float(xr.w & 0xffff0000u);
                    v[bj][0] = v0; v[bj][1] = v1;
                    if (MODE == 0) {
                        w[bj].x = pg8::cvt_pk_bf16(v0[0], v0[1]); w[bj].y = pg8::cvt_pk_bf16(v0[2], v0[3]); w[bj].z = pg8::cvt_pk_bf16(v1[0], v1[1]); w[bj].w = pg8::cvt_pk_bf16(v1[2], v1[3]);
                        const float r0 = __uint_as_float(w[bj].x << 16), r1 = __uint_as_float(w[bj].x & 0xffff0000u), r2 = __uint_as_float(w[bj].y << 16), r3 = __uint_as_float(w[bj].y & 0xffff0000u);
                        const float r4 = __uint_as_float(w[bj].z << 16), r5 = __uint_as_float(w[bj].z & 0xffff0000u), r6 = __uint_as_float(w[bj].w << 16), r7 = __uint_as_float(w[bj].w & 0xffff0000u);
                        ss += (r0 * r0 + r1 * r1) + (r2 * r2 + r3 * r3) + (r4 * r4 + r5 * r5) + (r6 * r6 + r7 * r7);
                    }
                }
                if (MODE == 0) {
                    epi_put16<DM>(w[0], w[1], xb + (size_t)(rowb + ai * 128 + m * 16) * DM + colb, sc, fr, fq, lane);
                    ss += __shfl_xor(ss, 16); ss += __shfl_xor(ss, 32); if (fq == 0) atomicAdd(rss + row, ss);
                } else {
#pragma unroll
                    for (int bj = 0; bj < 2; ++bj) epi_put32(v[bj][0], v[bj][1], out + (size_t)(rowb + ai * 128 + m * 16) * DM + colb + bj * 32, sc, fr, fq, lane);
                }
            }
    }
};
struct EpiOutFinal {
    static constexpr bool PERM = true, AFTER_DRAIN = false;
    float* out; const bf16_t* xb; const float* fnw; float* slots; unsigned* cnt; PG8_LAS unsigned char* xl; PG8_LAS unsigned char* xs;
    __device__ __forceinline__ void operator()(const pg8::f32x4 (&acc_)[2][2][4][2], const pg8::Unit& u, int wr, int wc, int fr, int fq) const {
        pg8::f32x4 (&acc)[2][2][4][2] = const_cast<pg8::f32x4 (&)[2][2][4][2]>(acc_);
        int tid_ = threadIdx.x; asm volatile("" : "+v"(tid_));
        const int tid = tid_, lane = tid & 63, wid = __builtin_amdgcn_readfirstlane(tid >> 6);
        PG8_LAS float* Pl = (PG8_LAS float*)xl; PG8_LAS float* Sl = (PG8_LAS float*)(xl + 4096); PG8_LAS unsigned* flag = (PG8_LAS unsigned*)(xl + 5120);
        const int row0 = u.pm * 256 + wr * 64 + fr, col0 = u.pn * 256 + wc * 64 + 8 * fq;
        PG8_LAS unsigned char* sc = xs + (wr * 4 + wc) * 2048;
#pragma unroll
        for (int ai = 0; ai < 2; ++ai)
#pragma unroll
            for (int m = 0; m < 4; ++m) {
                const size_t off = (size_t)(row0 + ai * 128 + m * 16) * DM + col0;
                float ss = 0.f;
#pragma unroll
                for (int bj = 0; bj < 2; ++bj) {
                    const pg8::u32x4 xr = *(const pg8::u32x4*)(xb + off + bj * 32);
                    pg8::f32x4& v0 = acc[ai][bj][m][0]; pg8::f32x4& v1 = acc[ai][bj][m][1];
                    v0[0] += __uint_as_float(xr.x << 16); v0[1] += __uint_as_float(xr.x & 0xffff0000u); v0[2] += __uint_as_float(xr.y << 16); v0[3] += __uint_as_float(xr.y & 0xffff0000u);
                    v1[0] += __uint_as_float(xr.z << 16); v1[1] += __uint_as_float(xr.z & 0xffff0000u); v1[2] += __uint_as_float(xr.w << 16); v1[3] += __uint_as_float(xr.w & 0xffff0000u);
                    ss += (v0[0] * v0[0] + v0[1] * v0[1]) + (v0[2] * v0[2] + v0[3] * v0[3]) + (v1[0] * v1[0] + v1[1] * v1[1]) + (v1[2] * v1[2] + v1[3] * v1[3]);
                }
                ss += __shfl_xor(ss, 16); ss += __shfl_xor(ss, 32);
                if (fq == 0) Pl[(ai * 128 + wr * 64 + m * 16 + fr) * 4 + wc] = ss;
            }
        asm volatile("s_waitcnt lgkmcnt(0)\n\ts_barrier" ::: "memory");
        if (tid < 256) {
            const float s = (Pl[tid * 4] + Pl[tid * 4 + 1]) + (Pl[tid * 4 + 2] + Pl[tid * 4 + 3]);
            __hip_atomic_store(slots + ((size_t)(u.pm * 256 + tid) * 4 + u.pn), s, __ATOMIC_RELAXED, __HIP_MEMORY_SCOPE_AGENT);
        }
        asm volatile("s_waitcnt vmcnt(0)" ::: "memory");
        if (lane == 0) __hip_atomic_fetch_add(cnt + 64 * u.pm, 1u, __ATOMIC_RELAXED, __HIP_MEMORY_SCOPE_AGENT);
        if (wid == 0) {
            unsigned sp = 0;
            while ((unsigned)__builtin_amdgcn_readfirstlane(__hip_atomic_load(cnt + 64 * u.pm, __ATOMIC_RELAXED, __HIP_MEMORY_SCOPE_AGENT)) < 32u && ++sp < (1u << 22)) __builtin_amdgcn_s_sleep(1);
            __builtin_amdgcn_fence(__ATOMIC_ACQUIRE, "agent");
            if (lane == 0) flag[0] = sp;
        }
        asm volatile("s_waitcnt vmcnt(0) lgkmcnt(0)\n\ts_barrier" ::: "memory");
        if (tid < 256) {
            const float* sl = slots + (size_t)(u.pm * 256 + tid) * 4; float t = 0.f;
#pragma unroll
            for (int k = 0; k < 4; ++k) t += __hip_atomic_load(sl + k, __ATOMIC_RELAXED, __HIP_MEMORY_SCOPE_AGENT);
            Sl[tid] = rsqrtf(t * (1.f / DM) + EPS);
        }
        asm volatile("s_waitcnt vmcnt(0) lgkmcnt(0)\n\ts_barrier" ::: "memory");
        pg8::f32x4 w0[2], w1[2];
#pragma unroll
        for (int bj = 0; bj < 2; ++bj) { w0[bj] = *(const pg8::f32x4*)(fnw + col0 + bj * 32); w1[bj] = *(const pg8::f32x4*)(fnw + col0 + bj * 32 + 4); }
        const int lane_ = fq * 16 + fr;
#pragma unroll
        for (int ai = 0; ai < 2; ++ai)
#pragma unroll
            for (int m = 0; m < 4; ++m) {
                const int rl = ai * 128 + wr * 64 + m * 16 + fr; const float rs = Sl[rl];
#pragma unroll
                for (int bj = 0; bj < 2; ++bj)
                    epi_put32(acc[ai][bj][m][0] * rs * w0[bj], acc[ai][bj][m][1] * rs * w1[bj], out + (size_t)(u.pm * 256 + ai * 128 + wr * 64 + m * 16) * DM + u.pn * 256 + wc * 64 + bj * 32, sc, fr, fq, lane_);
            }
    }
};

__device__ __forceinline__ void ph_bias_table(const float* rel_bias, float* tbl, int gtid, int gsize) {
    for (int i = gtid; i < 4096; i += gsize) {
        int rel = i - 2048;
        int ret = rel > 0 ? 16 : 0;
        int n = rel < 0 ? -rel : rel;
        float nf = (float)(n > 1 ? n : 1);
        float lg = logf(nf / 8.0f) / 2.7725887298583984f * 8.0f;
        int large = 8 + (int)lg;
        if (large > 15) large = 15;
        int b = ret + (n < 8 ? n : large);
        for (int h = 0; h < 4; ++h) tbl[h * 4096 + i] = rel_bias[b * 4 + h] * 1.4426950408889634f;
    }
}
__device__ __forceinline__ void p0_transpose_item(const float* W, const float* sc, int K, int N, bf16_t* WT, LAS float* scr, int item, int lane, int nlim, float nscale, bool perm) {
    const int nblk = N / 32, kb = item / nblk, nb = item % nblk, k0 = 64 * kb, n0 = 32 * nb; const float ns = n0 < nlim ? nscale : 1.f;
    int n0o = n0; if (perm) { const int tb = n0 & ~255, rel = n0 & 255; n0o = tb + ((rel >> 5) & 1) * 128 + (rel >> 6) * 32; }
    float v[32];
#pragma unroll
    for (int i = 0; i < 32; ++i) v[i] = W[(size_t)(k0 + 2 * i + (lane >> 5)) * N + n0 + (lane & 31)];
    if (sc) {
#pragma unroll
        for (int i = 0; i < 32; ++i) v[i] *= sc[k0 + 2 * i + (lane >> 5)] * ns;
    }
#pragma unroll
    for (int i = 0; i < 32; ++i) scr[(2 * i + (lane >> 5)) * 33 + (lane & 31)] = v[i];
    asm volatile("s_waitcnt lgkmcnt(0)" ::: "memory");
    const int c = lane & 7;
#pragma unroll
    for (int j = 0; j < 4; ++j) { const int n = (lane >> 3) + 8 * j; const LAS float* s = scr + (8 * c) * 33 + n;
        uint4 o; o.x = pk2(s[0 * 33], s[1 * 33]); o.y = pk2(s[2 * 33], s[3 * 33]); o.z = pk2(s[4 * 33], s[5 * 33]); o.w = pk2(s[6 * 33], s[7 * 33]);
        *(uint4*)(WT + (size_t)(n0o + n) * K + k0 + 8 * c) = o; }
    asm volatile("s_waitcnt lgkmcnt(0)" ::: "memory");
}
__device__ __forceinline__ void ph_prologue(const Params& P, float* lds) {
    unsigned char* ws = P.ws;
    int tid_ = threadIdx.x; asm volatile("" : "+v"(tid_));
    const int lane = tid_ & 63, wave = tid_ >> 6;
    const int gw = blockIdx.x * (NT / 64) + wave, ngw = gridDim.x * (NT / 64);
    ph_bias_table(P.rel_bias, (float*)(ws + WS_BIAS), blockIdx.x * NT + tid_, gridDim.x * NT);
    {
        float2* rot = (float2*)(ws + WS_ROT);
        for (int i = blockIdx.x * NT + tid_; i < SEQ * 32; i += gridDim.x * NT) {
            const int pr = i & 31, pos = i >> 5;
            const float theta = 1.0f / powf(10000.0f, (float)pr / 31.0f);
            const float ang = (float)pos * theta;
            rot[i] = make_float2(cosf(ang), sinf(ang));
        }
    }
    LAS float* scr = (LAS float*)lds + wave * (64 * 33);
    constexpr int I_IN = (DM / 64) * (DIN / 32), I_OUT = (DMIX / 64) * (DM / 32);
    constexpr int I_PW = (128 / 64) * (128 / 32);
    for (int it = gw; it < 8 * I_PW; it += ngw) { const int mtx = it / I_PW; p0_transpose_item(P.pool_w + (size_t)mtx * 128 * 128, nullptr, 128, 128, (bf16_t*)(ws + (28u << 20)) + (size_t)mtx * 128 * 128, scr, it % I_PW, lane, 0, 1.f, false); }
    for (int it = gw; it < 2 * (I_IN + I_OUT); it += ngw) {
        int r = it;
        if (r < 2 * I_IN) { const int l = r / I_IN; r -= l * I_IN; p0_transpose_item(P.w_in + (size_t)l * DM * DIN, P.norm_w + l * DM, DM, DIN, (bf16_t*)(ws + WS_WIN) + (size_t)l * DIN * DM, scr, r, lane, 512, 0.125f * 1.4426950408889634f, true); }
        else { r -= 2 * I_IN; const int l = r / I_OUT; r -= l * I_OUT; p0_transpose_item(P.w_out + (size_t)l * DMIX * DM, nullptr, DMIX, DM, (bf16_t*)(ws + WS_WOUT) + (size_t)l * DM * DMIX, scr, r, lane, 0, 1.f, true); }
    }
    float* rss0 = (float*)(ws + WS_RSS0); float* rss1 = (float*)(ws + WS_RSS1); bf16_t* xb = (bf16_t*)(ws + WS_XB);
    for (int row0 = gw * 4; row0 < T; row0 += ngw * 4) {
        float4 v[4][4];
#pragma unroll
        for (int q = 0; q < 4; ++q) { const float4* p = (const float4*)(P.x + (size_t)(row0 + q) * DM);
#pragma unroll
            for (int j = 0; j < 4; ++j) v[q][j] = p[lane + 64 * j]; }
#pragma unroll
        for (int q = 0; q < 4; ++q) {
            uint2* o = (uint2*)(xb + (size_t)(row0 + q) * DM);
            float s = 0.f;
#pragma unroll
            for (int j = 0; j < 4; ++j) { const float4 t = v[q][j]; s += t.x * t.x + t.y * t.y + t.z * t.z + t.w * t.w; uint2 w; w.x = pk2(t.x, t.y); w.y = pk2(t.z, t.w); o[lane + 64 * j] = w; }
#pragma unroll
            for (int of = 32; of > 0; of >>= 1) s += __shfl_xor(s, of);
            if (lane == 0) { rss0[row0 + q] = s; rss1[row0 + q] = 0.f; }
        }
    }
}

__device__ __forceinline__ void ph_final_norm(float* x, const float* w) {
    int tid_ = threadIdx.x; asm volatile("" : "+v"(tid_));
    const int lane = tid_ & 63, gw = blockIdx.x * (NT / 64) + (tid_ >> 6), ngw = gridDim.x * (NT / 64);
    for (int row = gw; row < T; row += ngw) {
        float4* p = (float4*)(x + (size_t)row * DM);
        float4 v[4]; float s = 0.f;
        for (int j = 0; j < 4; ++j) { v[j] = p[lane + 64 * j]; s += v[j].x * v[j].x + v[j].y * v[j].y + v[j].z * v[j].z + v[j].w * v[j].w; }
        for (int o = 32; o > 0; o >>= 1) s += __shfl_xor(s, o);
        const float r = rsqrtf(s * (1.f / DM) + EPS);
        for (int j = 0; j < 4; ++j) { float4 ww = ((const float4*)w)[lane + 64 * j]; float4 o4; o4.x = v[j].x * r * ww.x; o4.y = v[j].y * r * ww.y; o4.z = v[j].z * r * ww.z; o4.w = v[j].w * r * ww.w; p[lane + 64 * j] = o4; }
    }
}


namespace att {
#define ATT_LAS __attribute__((address_space(3)))
typedef short bf16x8 __attribute__((ext_vector_type(8)));
typedef short s16x4 __attribute__((ext_vector_type(4)));
typedef float f32x16 __attribute__((ext_vector_type(16)));
typedef ATT_LAS unsigned char* ldsp;
typedef unsigned u32x4 __attribute__((ext_vector_type(4)));
__device__ __forceinline__ int crow(int reg, int hh) { return (reg & 3) + 8 * (reg >> 2) + 4 * hh; }
__device__ __forceinline__ s16x4 vtr(ldsp p) { return __builtin_bit_cast(s16x4, __builtin_amdgcn_ds_read_tr16_b64_v4i16((ATT_LAS s16x4*)p)); }
typedef float f32x2_t __attribute__((ext_vector_type(2))); typedef __bf16 bf16x2_t __attribute__((ext_vector_type(2)));
__device__ __forceinline__ unsigned cvtpk(float lo, float hi) { f32x2_t v = {lo, hi}; bf16x2_t b = __builtin_convertvector(v, bf16x2_t); return __builtin_bit_cast(unsigned, b); }
#define ATT_MFMA(a, b, c) __builtin_amdgcn_mfma_f32_32x32x16_bf16((a), (b), (c), 0, 0, 0)

constexpr float ATT_THR = 6.0f;
__device__ __forceinline__ float max3f(float a, float b, float c) { float r; asm("v_max3_f32 %0, %1, %2, %3" : "=v"(r) : "v"(a), "v"(b), "v"(c)); return r; }
__device__ __forceinline__ float rowmax32(const f32x16& p0, const f32x16& p1) {
    float a = max3f(p0[0], p0[1], p1[0]), b = max3f(p0[2], p0[3], p1[1]); a = max3f(a, p1[2], p1[3]);
#pragma unroll
    for (int i = 4; i < 16; i += 4) { a = max3f(a, p0[i], p0[i + 1]); b = max3f(b, p0[i + 2], p0[i + 3]); a = max3f(a, p1[i], p1[i + 1]); b = max3f(b, p1[i + 2], p1[i + 3]); }
    float m = max3f(a, b, b);
    auto rr = __builtin_amdgcn_permlane32_swap(__float_as_uint(m), __float_as_uint(m), false, false);
    return max3f(__uint_as_float(rr[0]), __uint_as_float(rr[1]), m);
}

#define ATT_WAIT_BAR(N) asm volatile("s_waitcnt vmcnt(" #N ") lgkmcnt(0)\n\ts_barrier" ::: "memory")
#define ATT_ISSUE_K(pb, t) do { _Pragma("unroll") for (int i_ = 0; i_ < 2; ++i_) dma16((pb), ksrc[i_] + (unsigned)(t) * (128u * DIN), (unsigned)(size_t)(lds + KR + ((t) & 3) * 16384 + wid * 2048 + i_ * 1024)); } while (0)
#define ATT_ISSUE_V(pb, t) do { _Pragma("unroll") for (int i_ = 0; i_ < 2; ++i_) dma16((pb), vsrc[i_] + (unsigned)(t) * (128u * DIN), (unsigned)(size_t)(lds + VR + ((t) & 3) * 16384 + wid * 2048 + i_ * 1024)); } while (0)
#define ATT_LANE_SETUP() \
    int tid_ = threadIdx.x; asm volatile("" : "+v"(tid_)); \
    const int tid = tid_, lane = tid & 63, wid = __builtin_amdgcn_readfirstlane(tid >> 6), r = lane & 31, hh = lane >> 5; \
    const int mp = wid & 1, qs = wid >> 1, q0 = qblk * 128 + qs * 32; \
    unsigned ksrc[2], vsrc[2]; \
    _Pragma("unroll") for (int i = 0; i < 2; ++i) { \
        const int krow = 8 * wid + 4 * i + (lane >> 4), kc = (lane & 15) ^ (krow & 15); \
        ksrc[i] = 2u * (unsigned)(krow * DIN + C_AK + h * 128 + kc * 8); \
        const int vrow = 8 * wid + ((lane >> 2) & 7), vc = 4 * (2 * i + (lane >> 5)) + (lane & 3); \
        vsrc[i] = 2u * (unsigned)(vrow * DIN + C_AV + h * 128 + vc * 8); }
template <int TRAIL>
__device__ __forceinline__ void attn_run(ldsp lds, int i_lo, int i_hi, int xg  , int qblk, const bf16_t* __restrict__ proj, const float* __restrict__ tbl2, float lam, int layer, const float* __restrict__ subln_w, bf16_t* __restrict__ mixed) {
    if (i_lo >= i_hi) return;
    const int h = xg & 3;
    constexpr int NTILE = SEQ / 64;
    constexpr int KR = 0, VR = 65536, TBO = 131072, XB = 133120;
    __syncthreads();
    {
        ATT_LANE_SETUP();
        (void)r; (void)hh; (void)mp; (void)q0;
        const float tv = tbl2[h * 4096 + 2048 - 256 + tid]; ATT_LAS float* tbw = (ATT_LAS float*)(lds + TBO); tbw[tid] = tv;
        const bf16_t* pb0 = proj + (size_t)((i_lo * 16 + xg) >> 2) * SEQ * DIN;
        ATT_ISSUE_K(pb0, 0); ATT_ISSUE_V(pb0, 0); ATT_ISSUE_K(pb0, 1); ATT_ISSUE_V(pb0, 1);
    }
#define ATT_SIDE(t) (((t) * 64 + 63 - q0 <= -128) ? 0 : (((t) * 64 - (q0 + 31) >= 128) ? 2 : 1))
#define ATT_QK(P0, P1, t) do { const ldsp kp_ = lds + ((t) & 3) * 16384 + kbase; \
        f32x16 cin_; { const float c_ = (ATT_SIDE(t) == 2 ? bias_pos : bias_neg) - mref; _Pragma("unroll") for (int i_ = 0; i_ < 16; ++i_) cin_[i_] = c_; } \
        _Pragma("unroll") for (int s_ = 0; s_ < 4; ++s_) { const int co_ = ((mp * 8 + 2 * s_ + hh) ^ kx) * 16; \
            const bf16x8 ka_ = *(const ATT_LAS bf16x8*)(kp_ + co_), kb_ = *(const ATT_LAS bf16x8*)(kp_ + 8192 + co_); \
            if (s_ == 0) { P0 = ATT_MFMA(ka_, qf[0], cin_); P1 = ATT_MFMA(kb_, qf[0], cin_); } else { P0 = ATT_MFMA(ka_, qf[s_], P0); P1 = ATT_MFMA(kb_, qf[s_], P1); } } } while (0)
#define ATT_NEARFIX(P0, P1, t) do { if (ATT_SIDE(t) == 1) { const int rb_ = (t) * 64 - (q0 + r) + 256 + 4 * hh; \
            _Pragma("unroll") for (int i_ = 0; i_ < 16; ++i_) { const int k_ = rb_ + (i_ & 3) + 8 * (i_ >> 2); P0[i_] += tb[k_] - bias_neg; P1[i_] += tb[k_ + 32] - bias_neg; } } } while (0)
#define ATT_SB() __builtin_amdgcn_sched_barrier(0)
#define ATT_KRD(s_, half_) (*(const ATT_LAS bf16x8*)(kp_ + (half_) * 8192 + ((mp * 8 + 2 * (s_) + hh) ^ kx) * 16))
#define ATT_VRD(DST, j_) do { const s16x4 lo_ = vtr(vp_ + (2 * ((j_) >> 2)) * 2048 + ((j_) & 3) * 512), hi_ = vtr(vp_ + (2 * ((j_) >> 2) + 1) * 2048 + ((j_) & 3) * 512); \
        DST = (bf16x8){lo_[0], lo_[1], lo_[2], lo_[3], hi_[0], hi_[1], hi_[2], hi_[3]}; } while (0)
#define ATT_EXP8(P, i0) do { _Pragma("unroll") for (int i_ = (i0); i_ < (i0) + 8; ++i_) P[i_] = __builtin_amdgcn_exp2f(P[i_]); } while (0)
#define ATT_PACK(DST, P, i0) do { u32x4 wv_; _Pragma("unroll") for (int j_ = 0; j_ < 4; ++j_) wv_[j_] = cvtpk(P[(i0) + 2 * j_], P[(i0) + 2 * j_ + 1]); DST = __builtin_bit_cast(bf16x8, wv_); } while (0)
#define ATT_SUM8(P, i0) do { _Pragma("unroll") for (int i_ = (i0); i_ < (i0) + 8; ++i_) l += P[i_]; } while (0)
#define ATT_KPRE(tq) do { const ldsp kp_ = lds + ((tq) & 3) * 16384 + kbase; ka0_ = ATT_KRD(0, 0); kb0_ = ATT_KRD(0, 1); ka1_ = ATT_KRD(1, 0); kb1_ = ATT_KRD(1, 1); } while (0)
#define ATT_QKEXP(PC0, PC1, PN0, PN1, tq, tv, KPRE) do { \
        const ldsp kp_ = lds + ((tq) & 3) * 16384 + kbase; const ldsp vp_ = lds + ((tv) & 3) * 16384 + vbase; \
        { const float c_ = (ATT_SIDE(tq) == 2 ? bias_pos : bias_neg) - mref; if (__any(c_ != ccur_)) { ccur_ = c_; _Pragma("unroll") for (int i_ = 0; i_ < 16; ++i_) cin_[i_] = c_; } } \
        if (!(KPRE)) { ka0_ = ATT_KRD(0, 0); kb0_ = ATT_KRD(0, 1); ka1_ = ATT_KRD(1, 0); kb1_ = ATT_KRD(1, 1); } \
        ATT_SB(); \
        ATT_EXP8(PC0, 0); \
        ATT_SB(); \
        PN0 = ATT_MFMA(ka0_, qf[0], cin_); PN1 = ATT_MFMA(kb0_, qf[0], cin_); ka0_ = ATT_KRD(2, 0); kb0_ = ATT_KRD(2, 1); ATT_EXP8(PC0, 8); \
        ATT_SB(); \
        PN0 = ATT_MFMA(ka1_, qf[1], PN0); PN1 = ATT_MFMA(kb1_, qf[1], PN1); ka1_ = ATT_KRD(3, 0); kb1_ = ATT_KRD(3, 1); ATT_EXP8(PC1, 0); \
        ATT_SB(); \
        PN0 = ATT_MFMA(ka0_, qf[2], PN0); PN1 = ATT_MFMA(kb0_, qf[2], PN1); ATT_VRD(vf0_, 0); ATT_VRD(vf1_, 1); ATT_EXP8(PC1, 8); \
        ATT_SB(); \
        PN0 = ATT_MFMA(ka1_, qf[3], PN0); PN1 = ATT_MFMA(kb1_, qf[3], PN1); ATT_VRD(vf2_, 2); ATT_VRD(vf3_, 3); ATT_PACK(pk0_, PC0, 0); ATT_SUM8(PC0, 0); \
        ATT_SB(); } while (0)
#define ATT_PV4(g_, PKCUR, NEXTWORK) do { \
        o[0] = ATT_MFMA(vf0_, PKCUR, o[0]); if ((g_) < 3) ATT_VRD(vf0_, 4 * (g_) + 4); NEXTWORK; ATT_SB(); \
        o[1] = ATT_MFMA(vf1_, PKCUR, o[1]); if ((g_) < 3) ATT_VRD(vf1_, 4 * (g_) + 5); ATT_SB(); \
        o[2] = ATT_MFMA(vf2_, PKCUR, o[2]); if ((g_) < 3) ATT_VRD(vf2_, 4 * (g_) + 6); ATT_SB(); \
        o[3] = ATT_MFMA(vf3_, PKCUR, o[3]); if ((g_) < 3) ATT_VRD(vf3_, 4 * (g_) + 7); ATT_SB(); } while (0)
#define ATT_PVBLOCK(PC0, PC1, tv, RMWORK, TAILWORK) do { const ldsp vp_ = lds + ((tv) & 3) * 16384 + vbase; bf16x8 pk1_; __builtin_amdgcn_s_setprio(1); \
        ATT_PV4(0, pk0_, do { ATT_PACK(pk1_, PC0, 8); ATT_SUM8(PC0, 8); } while (0)); \
        ATT_PV4(1, pk1_, do { ATT_PACK(pk0_, PC1, 0); ATT_SUM8(PC1, 0); } while (0)); \
        ATT_PV4(2, pk0_, do { ATT_PACK(pk1_, PC1, 8); ATT_SUM8(PC1, 8); RMWORK; } while (0)); \
        ATT_PV4(3, pk1_, TAILWORK); __builtin_amdgcn_s_setprio(0); } while (0)
#define ATT_RESCALE(P0, P1) do { \
        if (__any(mt_ > ATT_THR)) { const float dl_ = mt_ > ATT_THR ? mt_ : 0.f; const float f_ = __builtin_amdgcn_exp2f(-dl_); mref += dl_; l *= f_; \
            _Pragma("unroll") for (int d_ = 0; d_ < 4; ++d_) _Pragma("unroll") for (int i_ = 0; i_ < 16; ++i_) o[d_][i_] *= f_; \
            _Pragma("unroll") for (int i_ = 0; i_ < 16; ++i_) { P0[i_] -= dl_; P1[i_] -= dl_; } } } while (0)
#define ATT_DMA(t) do { if ((t) + 2 < NTILE) ATT_ISSUE_V(pbat, (t) + 2); if ((t) + 4 < NTILE) ATT_ISSUE_K(pbat, (t) + 4); } while (0)
#define ATT_CLOSE(t) do { if ((t) + 4 < NTILE) ATT_WAIT_BAR(6); else if ((t) + 4 == NTILE) ATT_WAIT_BAR(4); else if ((t) + 3 == NTILE) ATT_WAIT_BAR(2); else ATT_WAIT_BAR(0); } while (0)
#define ATT_STEP_L(PC0, PC1, PN0, PN1, t) do { float mt_ = 0.f; \
        ATT_DMA(t); \
        ATT_QKEXP(PC0, PC1, PN0, PN1, (t) + 1, t, false); \
        if ((t) + 1 < NTILE) ATT_NEARFIX(PN0, PN1, (t) + 1); \
        ATT_PVBLOCK(PC0, PC1, t, mt_ = rowmax32(PN0, PN1), (void)0); \
        if ((t) + 1 < NTILE) ATT_RESCALE(PN0, PN1); \
        ATT_CLOSE(t); } while (0)
#define ATT_STEP_T(PP0, PP1, PC0, PC1, t) do { float mt_ = 0.f; \
        if ((t) > 0) { ATT_NEARFIX(PC0, PC1, t); ATT_PVBLOCK(PP0, PP1, (t) - 1, mt_ = rowmax32(PC0, PC1), ATT_KPRE((t) + 1)); ATT_RESCALE(PC0, PC1); } else ATT_KPRE((t) + 1); \
        ATT_DMA(t);                                                \
        ATT_QKEXP(PC0, PC1, PP0, PP1, (t) + 1, t, true);          \
        ATT_CLOSE(t); } while (0)
    bf16x8 qf[4];
    {
        ATT_LANE_SETUP();
        (void)ksrc; (void)vsrc;
        const bf16_t* qp = proj + ((size_t)((i_lo * 16 + xg) >> 2) * SEQ + q0 + r) * DIN + C_AQ + h * 128 + mp * 64 + hh * 8;
#pragma unroll
        for (int s = 0; s < 4; ++s) qf[s] = *(const bf16x8*)(qp + 16 * s);
    }
    for (int it = i_lo; it < i_hi; ++it) {
        ATT_LANE_SETUP();
        const int b = (it * 16 + xg) >> 2;
        const size_t tok0 = (size_t)b * SEQ;
        const bf16_t* pbat = proj + tok0 * DIN;
        const ATT_LAS float* tb = (const ATT_LAS float*)(lds + TBO);
        const int kbase = KR + r * 256, kx = r & 15;
        const int vbase = VR + (4 * hh + ((lane & 15) >> 2)) * 64 + ((lane >> 4) & 1) * 32 + (lane & 3) * 8;
        asm volatile("s_waitcnt lgkmcnt(0)\n\ts_barrier" ::: "memory");
        ATT_ISSUE_K(pbat, 2); ATT_ISSUE_K(pbat, 3);
        ATT_WAIT_BAR(10);
        const float bias_neg = tb[0], bias_pos = tb[511];
        f32x16 o[4];
#pragma unroll
        for (int d = 0; d < 4; ++d)
#pragma unroll
            for (int i = 0; i < 16; ++i) o[d][i] = 0.f;
        float mref = 0.f, l = 0.f;
        f32x16 pA0, pA1, pB0, pB1;
        ATT_QK(pA0, pA1, 0); ATT_NEARFIX(pA0, pA1, 0);
        { const float m0 = rowmax32(pA0, pA1); mref = m0;
#pragma unroll
          for (int i = 0; i < 16; ++i) { pA0[i] -= m0; pA1[i] -= m0; } }
        asm volatile("s_waitcnt lgkmcnt(0)\n\ts_barrier" ::: "memory");
        bf16x8 vf0_, vf1_, vf2_, vf3_, pk0_, ka0_, kb0_, ka1_, kb1_;
        f32x16 cin_; float ccur_ = __builtin_nanf("");
        if constexpr (TRAIL == 0) {
            for (int t = 0; t < NTILE; t += 2) {
                ATT_STEP_L(pA0, pA1, pB0, pB1, t);
                ATT_STEP_L(pB0, pB1, pA0, pA1, t + 1);
            }
        } else {
            for (int t = 0; t < NTILE; t += 2) {
                ATT_STEP_T(pB0, pB1, pA0, pA1, t);
                ATT_STEP_T(pA0, pA1, pB0, pB1, t + 1);
            }
            { float mt_ = 0.f; (void)mt_; ATT_PVBLOCK(pB0, pB1, NTILE - 1, (void)0, (void)0); }
        }
        __builtin_amdgcn_s_setprio(0);
        if (it + 1 < i_hi) { const bf16_t* pbn = proj + (size_t)(((it + 1) * 16 + xg) >> 2) * SEQ * DIN; ATT_ISSUE_K(pbn, 0); ATT_ISSUE_V(pbn, 0); ATT_ISSUE_K(pbn, 1); ATT_ISSUE_V(pbn, 1); }
#define ATT_NEXT_Q() do { if (it + 1 < i_hi) { const bf16_t* qp_ = proj + ((size_t)(((it + 1) * 16 + xg) >> 2) * SEQ + q0 + r) * DIN + C_AQ + h * 128 + mp * 64 + hh * 8; \
            _Pragma("unroll") for (int s_ = 0; s_ < 4; ++s_) qf[s_] = *(const bf16x8*)(qp_ + 16 * s_); } } while (0)
        const size_t trow = tok0 + q0 + r;
        const float ltot = l + __shfl_xor(l, 32);
        const float inv = __builtin_amdgcn_rcpf(ltot);
        ATT_LAS float* xw = (ATT_LAS float*)(lds + (qs == 0 ? KR + 3 * 16384 : qs == 1 ? KR + 2 * 16384 : qs == 2 ? VR + 2 * 16384 : XB)) + lane;
        if (mp == 1) {
            const float sc1 = lam * inv;
#pragma unroll
            for (int d = 0; d < 4; ++d)
#pragma unroll
                for (int i = 0; i < 16; ++i) xw[(d * 16 + i) * 64] = o[d][i] * sc1;
            ATT_NEXT_Q();
            asm volatile("s_waitcnt lgkmcnt(0)\n\ts_barrier" ::: "memory");
        } else {
            u32x4 gr[8];
            { const bf16_t* gsrc0 = proj + (tok0 + q0) * DIN + C_AG + h * 128;
#pragma unroll
              for (int i = 0; i < 8; ++i) { const int e = lane + 64 * i; gr[i] = *(const u32x4*)(gsrc0 + (size_t)(e >> 4) * DIN + (e & 15) * 8); } }
            asm volatile("s_waitcnt lgkmcnt(0)\n\ts_barrier" ::: "memory");
            float ss = 0.f;
#pragma unroll
            for (int d = 0; d < 4; ++d) {
#pragma unroll
                for (int i = 0; i < 16; ++i) { const float v = o[d][i] * inv - xw[(d * 16 + i) * 64]; o[d][i] = v; ss += v * v; }
                asm volatile("" ::: "memory");
            }
            ss += __shfl_xor(ss, 32);
            int ly_ = layer; asm volatile("" : "+s"(ly_));
            const float rs = rsqrtf(ss * (1.f / 128.f) + EPS) * (ly_ == 0 ? 0.8f : 0.64449093f);
            typedef unsigned u32x2 __attribute__((ext_vector_type(2)));
            const ldsp tl = (ldsp)xw - lane * 4;
            bf16_t* odst = mixed + (tok0 + q0) * DMIX + h * 128;
#pragma unroll
            for (int i = 0; i < 8; ++i) { const int e = lane + 64 * i; const ldsp gd = tl + (e >> 4) * 264 + (e & 15) * 16; *(ATT_LAS u32x2*)gd = (u32x2){gr[i][0], gr[i][1]}; *(ATT_LAS u32x2*)(gd + 8) = (u32x2){gr[i][2], gr[i][3]}; }
            ATT_NEXT_Q();
            asm volatile("s_waitcnt lgkmcnt(0)" ::: "memory");
            const ldsp tr_ = tl + r * 264 + 8 * hh;
#pragma unroll
            for (int d = 0; d < 4; ++d)
#pragma unroll
                for (int g = 0; g < 4; ++g) {
                    const int dd = d * 32 + 8 * g;
                    const u32x2 gv = *(const ATT_LAS u32x2*)(tr_ + dd * 2);
                    const float4 sw = *(const float4*)(subln_w + dd + 4 * hh);
                    const float g0 = __uint_as_float(gv.x << 16), g1 = __uint_as_float(gv.x & 0xffff0000u), g2 = __uint_as_float(gv.y << 16), g3 = __uint_as_float(gv.y & 0xffff0000u);
                    u32x2 w; w.x = pk2(o[d][4 * g] * rs * sw.x * g0, o[d][4 * g + 1] * rs * sw.y * g1); w.y = pk2(o[d][4 * g + 2] * rs * sw.z * g2, o[d][4 * g + 3] * rs * sw.w * g3);
                    *(ATT_LAS u32x2*)(tr_ + dd * 2) = w;
                }
            asm volatile("s_waitcnt lgkmcnt(0)" ::: "memory");
#pragma unroll
            for (int i = 0; i < 8; ++i) { const int e = lane + 64 * i; const ldsp od = tl + (e >> 4) * 264 + (e & 15) * 16; const u32x2 a0 = *(const ATT_LAS u32x2*)od, a1 = *(const ATT_LAS u32x2*)(od + 8);
                *(u32x4*)(odst + (size_t)(e >> 4) * DMIX + (e & 15) * 8) = (u32x4){a0.x, a0.y, a1.x, a1.y}; }
        }
    }
    asm volatile("s_waitcnt vmcnt(0)" ::: "memory");
#undef ATT_ISSUE_K
#undef ATT_WAIT_BAR
#undef ATT_ISSUE_V
#undef ATT_LANE_SETUP
#undef ATT_SIDE
#undef ATT_QK
#undef ATT_NEARFIX
#undef ATT_STEP_L
#undef ATT_STEP_T
#undef ATT_QKEXP
#undef ATT_KPRE
#undef ATT_PVBLOCK
#undef ATT_RESCALE
#undef ATT_DMA
#undef ATT_CLOSE
#undef ATT_NEXT_Q
#undef ATT_SB
#undef ATT_KRD
#undef ATT_VRD
#undef ATT_EXP8
#undef ATT_PACK
#undef ATT_SUM8
#undef ATT_PV4
}
__device__ __forceinline__ void attn_phase(ldsp lds, int i_lo, int i_hi, const bf16_t* proj, const float* tbl2, const float* diff_lambda, int layer, const float* subln_w, bf16_t* mixed) {
    asm volatile("" : "+s"(layer));
    float s01 = 0.f, s23 = 0.f;
    for (int d = 0; d < 64; ++d) { s01 += diff_lambda[d] * diff_lambda[64 + d]; s23 += diff_lambda[128 + d] * diff_lambda[192 + d]; }
    const float lamv = expf(s01) - expf(s23) + (layer == 0 ? 0.2f : 0.35550907f);
    const float lam = __builtin_bit_cast(float, __builtin_amdgcn_readfirstlane(__builtin_bit_cast(int, lamv)));
    const int bid = blockIdx.x, xcd = bid & 7, slot = bid >> 3;
    if (__builtin_amdgcn_readfirstlane((int)threadIdx.x >> 6) >= 4) attn_run<1>(lds, i_lo, i_hi, xcd * 2 + (slot >> 4), slot & 15, proj, tbl2, lam, layer, subln_w, mixed);
    else attn_run<0>(lds, i_lo, i_hi, xcd * 2 + (slot >> 4), slot & 15, proj, tbl2, lam, layer, subln_w, mixed);
}
}

namespace ret {
using att::ldsp; using att::bf16x8; using att::s16x4; using att::f32x16; using att::u32x4; using att::vtr; using att::cvtpk; using att::crow;
constexpr size_t WS_RST = 480 * MiB;
__device__ __forceinline__ float log2_sigmoid(float x) { return -log1pf(expf(-x)) * 1.4426950408889634f; }

__device__ __forceinline__ void ret_state_item(ldsp lds, int item, const bf16_t* __restrict__ proj, const float* __restrict__ decay_logit, bf16_t* __restrict__ rst, unsigned* cnt) {
    int tid_ = threadIdx.x; asm volatile("" : "+v"(tid_));
    const int tid = tid_, lane = tid & 63, wid = __builtin_amdgcn_readfirstlane(tid >> 6), r = lane & 31, hh = lane >> 5;
    const int vhalf = item & 1, dir = (item >> 1) & 1, h = (item >> 2) & 3, b = item >> 4;
    const int dblk = wid & 1, vblk = (wid >> 1) & 1;
    const float lg2 = log2_sigmoid(decay_logit[dir * 4 + h]);
    const float cd = __builtin_amdgcn_exp2f(lg2 * 128.f);
    const size_t tok0 = (size_t)b * SEQ;
    constexpr int KT = 0, VT = 16384, STG = 32768;
    const int m0 = tid >> 3, c8 = tid & 7;
    const unsigned gk = (unsigned)((tok0 + m0) * DIN + C_BK + h * 64 + c8 * 8), gv = (unsigned)((tok0 + m0) * DIN + C_BV + h * 128 + vhalf * 64 + c8 * 8);
    const int ldst = ((m0 >> 3) * 2 + (c8 >> 2)) * 512 + (m0 & 7) * 64 + (c8 & 3) * 16;
    const float sc0 = 0.125f * __builtin_amdgcn_exp2f(lg2 * (float)(dir == 0 ? 127 - m0 : m0)), sc1 = 0.125f * __builtin_amdgcn_exp2f(lg2 * (float)(dir == 0 ? 63 - m0 : m0 + 64));
    u32x4 kA[2], vA[2], kB[2], vB[2];
#define RS_ISSUE(KR, VR, c) do { _Pragma("unroll") for (int i_ = 0; i_ < 2; ++i_) { const unsigned o_ = (unsigned)((c) * 128 + 64 * i_) * DIN; KR[i_] = *(const u32x4*)(proj + gk + o_); VR[i_] = *(const u32x4*)(proj + gv + o_); } } while (0)
#define RS_COMMIT(KR, VR, buf) do { _Pragma("unroll") for (int i_ = 0; i_ < 2; ++i_) { const float sc_ = i_ == 0 ? sc0 : sc1; u32x4 w_; \
            _Pragma("unroll") for (int j_ = 0; j_ < 4; ++j_) { const unsigned u_ = KR[i_][j_]; w_[j_] = cvtpk(__uint_as_float(u_ << 16) * sc_, __uint_as_float(u_ & 0xffff0000u) * sc_); } \
            *(ATT_LAS u32x4*)(lds + (buf) * STG + KT + ldst + i_ * 8192) = w_; *(ATT_LAS u32x4*)(lds + (buf) * STG + VT + ldst + i_ * 8192) = VR[i_]; } } while (0)
#define RS_CHUNK(i) (dir == 0 ? (i) : 15 - (i))
    f32x16 acc;
#pragma unroll
    for (int i = 0; i < 16; ++i) acc[i] = 0.f;
    const int trb = ((lane & 15) >> 2) * 64 + ((lane >> 4) & 1) * 32 + (lane & 3) * 8 + hh * 1024;
#define RS_STEP(i, KR, VR) do { const int c_ = RS_CHUNK(i), buf_ = (i) & 1; \
        if (wid < 4) { bf16_t* dst_ = rst + ((((size_t)(b * 4 + h) * 16 + c_) * 2 + dir) * 128 + vhalf * 64 + vblk * 32 + r) * 64 + dblk * 32 + 4 * hh; \
            _Pragma("unroll") for (int g_ = 0; g_ < 4; ++g_) { uint2 w_; w_.x = cvtpk(acc[4 * g_], acc[4 * g_ + 1]); w_.y = cvtpk(acc[4 * g_ + 2], acc[4 * g_ + 3]); *(uint2*)(dst_ + 8 * g_) = w_; } \
            _Pragma("unroll") for (int k_ = 0; k_ < 16; ++k_) acc[k_] *= cd; \
            const ldsp kp_ = lds + buf_ * STG + KT + dblk * 512 + trb, vp_ = lds + buf_ * STG + VT + vblk * 512 + trb; \
            _Pragma("unroll") for (int ks_ = 0; ks_ < 8; ++ks_) { \
                const s16x4 alo_ = vtr(kp_ + ks_ * 2048), ahi_ = vtr(kp_ + ks_ * 2048 + 256), blo_ = vtr(vp_ + ks_ * 2048), bhi_ = vtr(vp_ + ks_ * 2048 + 256); \
                const bf16x8 a_ = {alo_[0], alo_[1], alo_[2], alo_[3], ahi_[0], ahi_[1], ahi_[2], ahi_[3]}, bb_ = {blo_[0], blo_[1], blo_[2], blo_[3], bhi_[0], bhi_[1], bhi_[2], bhi_[3]}; \
                acc = ATT_MFMA(a_, bb_, acc); } } \
        if ((i) + 1 < 16) RS_COMMIT(KR, VR, buf_ ^ 1); \
        if ((i) + 3 < 16) RS_ISSUE(KR, VR, RS_CHUNK((i) + 3)); \
        __syncthreads(); } while (0)
    __syncthreads();
    RS_ISSUE(kA, vA, RS_CHUNK(0)); RS_ISSUE(kB, vB, RS_CHUNK(1));
    RS_COMMIT(kA, vA, 0);
    RS_ISSUE(kA, vA, RS_CHUNK(2));
    __syncthreads();
    for (int i = 0; i < 16; i += 2) {
        RS_STEP(i, kB, vB);
        RS_STEP(i + 1, kA, vA);
    }
#undef RS_ISSUE
#undef RS_COMMIT
#undef RS_CHUNK
#undef RS_STEP
    asm volatile("s_waitcnt vmcnt(0)" ::: "memory");
    __syncthreads();
    if (tid == 0) { __builtin_amdgcn_fence(__ATOMIC_RELEASE, "agent"); asm volatile("s_waitcnt vmcnt(0)" ::: "memory"); __hip_atomic_fetch_add(cnt + (item >> 2), 1u, __ATOMIC_RELAXED, __HIP_MEMORY_SCOPE_AGENT); }
}
__device__ __forceinline__ void ret_wait_states(const unsigned* cnt, int bh0, int bh_stride, int n) {
    if (threadIdx.x == 0) {
        for (int i = 0; i < n; ++i) { unsigned sp = 0; while (__hip_atomic_load(cnt + bh0 + i * bh_stride, __ATOMIC_RELAXED, __HIP_MEMORY_SCOPE_AGENT) < 4u && ++sp < (1u << 20)) __builtin_amdgcn_s_sleep(2); }
        __builtin_amdgcn_fence(__ATOMIC_ACQUIRE, "agent"); asm volatile("s_waitcnt vmcnt(0)" ::: "memory");
    }
    __syncthreads();
}

__device__ __forceinline__ void ret_out_run(ldsp lds, int first, int stride, int nitems, const bf16_t* __restrict__ proj, const float* __restrict__ decay_logit, const bf16_t* __restrict__ rst, bf16_t* __restrict__ mixed) {
    int tid_ = threadIdx.x; asm volatile("" : "+v"(tid_));
    const int tid = tid_, lane = tid & 63, wid = __builtin_amdgcn_readfirstlane(tid >> 6), r = lane & 31, hh = lane >> 5;
    const int vhalf = wid & 1, nblk = wid >> 1;
    constexpr int KT = 0, VT = 16384, SLOT = 49152, RT = 2 * SLOT, SS = RT + 32768;
    unsigned ksrc[2], vsrc[4], rsrc[4];
#pragma unroll
    for (int i = 0; i < 2; ++i) { const int row = 16 * wid + 8 * i + (lane >> 3), ch = (lane & 7) ^ ((row >> 1) & 7); ksrc[i] = (unsigned)(row * DIN + C_BK + ch * 8); }
#pragma unroll
    for (int i = 0; i < 4; ++i) { const int row = 16 * wid + 8 * (i >> 1) + ((lane >> 2) & 7), ch = 4 * (2 * (i & 1) + (lane >> 5)) + (lane & 3); vsrc[i] = (unsigned)(row * DIN + C_BV + ch * 8); }
#pragma unroll
    for (int i = 0; i < 4; ++i) { const int pc = 4 * wid + i, row = 8 * (pc & 15) + (lane >> 3), ch = (lane & 7) ^ ((row >> 1) & 7); rsrc[i] = (unsigned)((pc >> 4) * 8192 + row * 64 + ch * 8); }
#define RO_DMA_KV(it, slot) do { const int c_ = (it) & 15, h_ = ((it) >> 4) & 3, b_ = (it) >> 6; const bf16_t* base_ = proj + ((size_t)b_ * SEQ + (size_t)c_ * 128) * DIN; \
        _Pragma("unroll") for (int i_ = 0; i_ < 2; ++i_) dma16(base_, 2u * (ksrc[i_] + (unsigned)h_ * 64u), (unsigned)(size_t)(lds + (slot) * SLOT + KT + wid * 2048 + i_ * 1024)); \
        _Pragma("unroll") for (int i_ = 0; i_ < 4; ++i_) dma16(base_, 2u * (vsrc[i_] + (unsigned)h_ * 128u), (unsigned)(size_t)(lds + (slot) * SLOT + VT + wid * 4096 + i_ * 1024)); } while (0)
#define RO_DMA_R(it) do { const bf16_t* base_ = rst + (size_t)((((it) >> 6) * 4 + (((it) >> 4) & 3)) * 16 + ((it) & 15)) * 2 * 8192; \
        _Pragma("unroll") for (int i_ = 0; i_ < 4; ++i_) dma16(base_, 2u * rsrc[i_], (unsigned)(size_t)(lds + RT + wid * 4096 + i_ * 1024)); } while (0)
#define RO_LOADQ(QF, it) do { const bf16_t* qp_ = proj + ((size_t)((it) >> 6) * SEQ + (size_t)((it) & 15) * 128 + nblk * 32 + r) * DIN + C_BQ + (((it) >> 4) & 3) * 64 + hh * 8; \
        _Pragma("unroll") for (int s_ = 0; s_ < 4; ++s_) QF[s_] = *(const bf16x8*)(qp_ + 16 * s_); } while (0)
    bf16x8 qn[4];
    __syncthreads();
    if (first < nitems) { RO_LOADQ(qn, first); RO_DMA_KV(first, 0); }
    asm volatile("s_waitcnt vmcnt(0)" ::: "memory");
    int slot = 0;
    for (int item = first; item < nitems; item += stride, slot ^= 1) {
        const int c = item & 15, h = (item >> 4) & 3, b = item >> 6;
        const float lgf = log2_sigmoid(decay_logit[h]), lgb = log2_sigmoid(decay_logit[4 + h]);
        const size_t tok0 = (size_t)b * SEQ + (size_t)c * 128;
        const int n = nblk * 32 + r;
        bf16x8 qf[4];
#pragma unroll
        for (int s = 0; s < 4; ++s) qf[s] = qn[s];
        asm volatile("s_waitcnt vmcnt(8) lgkmcnt(0)\n\ts_barrier" ::: "memory");
        RO_DMA_R(item);
        uint2 gvr[8];
        { const bf16_t* gp_ = proj + (tok0 + n) * DIN + C_BG + h * 128 + vhalf * 64 + 4 * hh;
#pragma unroll
          for (int j = 0; j < 8; ++j) gvr[j] = *(const uint2*)(gp_ + (j >> 2) * 32 + 8 * (j & 3)); }
        const bool has_next = item + stride < nitems;
        const ldsp kt = lds + slot * SLOT + KT, vt = lds + slot * SLOT + VT;
        f32x16 oi[2], of[2], ob[2];
#pragma unroll
        for (int v = 0; v < 2; ++v)
#pragma unroll
            for (int i = 0; i < 16; ++i) { oi[v][i] = 0.f; of[v][i] = 0.f; ob[v][i] = 0.f; }
        const int vbase = (4 * hh + ((lane & 15) >> 2)) * 64 + ((lane >> 4) & 1) * 32 + (lane & 3) * 8;
#pragma unroll
        for (int mb = 0; mb < 4; ++mb) {
            f32x16 p;
#pragma unroll
            for (int i = 0; i < 16; ++i) p[i] = 0.f;
            { const int m = mb * 32 + r; const int kb = m * 128, kx = (m >> 1) & 7;
#pragma unroll
              for (int s = 0; s < 4; ++s) { const bf16x8 ka = *(const ATT_LAS bf16x8*)(kt + kb + (((2 * s + hh) ^ kx) * 16)); p = ATT_MFMA(ka, qf[s], p); } }
#pragma unroll
            for (int i = 0; i < 16; ++i) {
                const int m = mb * 32 + crow(i, hh); const float dl = (float)(n - m);
                p[i] *= __builtin_amdgcn_exp2f(dl * (n >= m ? lgf : -lgb) - 3.f);
            }
#pragma unroll
            for (int s = 0; s < 2; ++s) {
                u32x4 wv;
#pragma unroll
                for (int j = 0; j < 4; ++j) wv[j] = cvtpk(p[8 * s + 2 * j], p[8 * s + 2 * j + 1]);
                const bf16x8 pb = __builtin_bit_cast(bf16x8, wv);
#pragma unroll
                for (int vb = 0; vb < 2; ++vb) {
                    const ldsp vp = vt + vbase + (vhalf * 2 + vb) * 512 + (4 * mb + 2 * s) * 2048;
                    const s16x4 lo = vtr(vp), hi = vtr(vp + 2048);
                    const bf16x8 va = {lo[0], lo[1], lo[2], lo[3], hi[0], hi[1], hi[2], hi[3]};
                    oi[vb] = ATT_MFMA(va, pb, oi[vb]);
                }
            }
        }
        asm volatile("s_waitcnt vmcnt(0) lgkmcnt(0)\n\ts_barrier" ::: "memory");
        if (has_next) RO_DMA_KV(item + stride, slot ^ 1);
#pragma unroll
        for (int vb = 0; vb < 2; ++vb) {
            const int v = vhalf * 64 + vb * 32 + r; const int rbase = RT + v * 128, rx = (v >> 1) & 7;
#pragma unroll
            for (int s = 0; s < 4; ++s) {
                const int co = ((2 * s + hh) ^ rx) * 16;
                const bf16x8 af = *(const ATT_LAS bf16x8*)(lds + rbase + co), ab = *(const ATT_LAS bf16x8*)(lds + rbase + 16384 + co);
                of[vb] = ATT_MFMA(af, qf[s], of[vb]); ob[vb] = ATT_MFMA(ab, qf[s], ob[vb]);
            }
        }
        const float qdf = __builtin_amdgcn_exp2f(lgf * (float)(n + 1)), qdb = __builtin_amdgcn_exp2f(lgb * (float)(128 - n));
        float ss = 0.f;
#pragma unroll
        for (int vb = 0; vb < 2; ++vb)
#pragma unroll
            for (int i = 0; i < 16; ++i) { const float v = oi[vb][i] + qdf * of[vb][i] + qdb * ob[vb][i]; oi[vb][i] = v; ss += v * v; }
        ss += __shfl_xor(ss, 32);
        ATT_LAS float* sx = (ATT_LAS float*)(lds + SS + (slot & 1) * 1024);
        if (hh == 0) sx[wid * 32 + r] = ss;
        asm volatile("s_waitcnt lgkmcnt(0)\n\ts_barrier" ::: "memory");
        const float tot = sx[wid * 32 + r] + sx[(wid ^ 1) * 32 + r];
        const float rs = rsqrtf(tot * (1.f / 128.f) + EPS);
        const size_t trow = tok0 + n;
        bf16_t* op = mixed + trow * DMIX + 512 + h * 128 + vhalf * 64 + 4 * hh;
        if (has_next) RO_LOADQ(qn, item + stride);
#pragma unroll
        for (int vb = 0; vb < 2; ++vb)
#pragma unroll
            for (int g = 0; g < 4; ++g) {
                const int dd = vb * 32 + 8 * g;
                const uint2 gv = gvr[vb * 4 + g];
                const float g0 = __uint_as_float(gv.x << 16), g1 = __uint_as_float(gv.x & 0xffff0000u), g2 = __uint_as_float(gv.y << 16), g3 = __uint_as_float(gv.y & 0xffff0000u);
                uint2 w; w.x = pk2(oi[vb][4 * g] * rs * g0, oi[vb][4 * g + 1] * rs * g1); w.y = pk2(oi[vb][4 * g + 2] * rs * g2, oi[vb][4 * g + 3] * rs * g3);
                *(uint2*)(op + dd) = w;
            }
    }
#undef RO_DMA_KV
#undef RO_DMA_R
#undef RO_LOADQ
}
}

namespace pool {
using att::ldsp; using att::bf16x8; using att::f32x16; using att::u32x4; using att::cvtpk; using att::crow;
typedef unsigned u32x2 __attribute__((ext_vector_type(2)));
constexpr size_t WS_PW = 28 * MiB;
__device__ __forceinline__ void pool_item(ldsp lds, int item, const bf16_t* __restrict__ proj, const bf16_t* __restrict__ pwT, const float* __restrict__ pool_scale, bf16_t* __restrict__ mixed) {
    int tid_ = threadIdx.x; asm volatile("" : "+v"(tid_));
    const int tid = tid_, lane = tid & 63, wid = __builtin_amdgcn_readfirstlane(tid >> 6), r = lane & 31, hh = lane >> 5;
    const int tokblk = wid >> 1, dhalf = wid & 1;
    const int t0 = item * 128, pos0 = t0 & (SEQ - 1);
    constexpr int RAW = 0, PL = 36864, GT = 69632, OT = 103424, RS = 264;
    u32x4 rreg[5];
#define PL_ISSUE(g) do { _Pragma("unroll") for (int i_ = 0; i_ < 5; ++i_) { const int e_ = tid + 512 * i_, row_ = e_ >> 4, pos_ = pos0 - 8 + row_; rreg[i_] = (u32x4){0u, 0u, 0u, 0u}; \
            if (e_ < 2304 && pos_ >= 0 && pos_ < SEQ) rreg[i_] = *(const u32x4*)(proj + (size_t)(t0 - 8 + row_) * DIN + C_CU + (g) * 128 + (e_ & 15) * 8); } } while (0)
#define PL_COMMIT() do { _Pragma("unroll") for (int i_ = 0; i_ < 5; ++i_) { const int e_ = tid + 512 * i_; if (e_ < 2304) *(ATT_LAS u32x4*)(lds + RAW + e_ * 16) = rreg[i_]; } } while (0)
    const int tok = tokblk * 32 + r;
    const size_t trow = (size_t)t0 + tok;
    __syncthreads();
    PL_ISSUE(0);
    PL_COMMIT();
    for (int g = 0; g < 4; ++g) {
        const int w2 = 1 << g;
        __syncthreads();
        bf16x8 af[2][8];
        { const bf16_t* wg = pwT + (size_t)g * 128 * 128 + (size_t)(dhalf * 64 + r) * 128 + hh * 8;
#pragma unroll
          for (int db = 0; db < 2; ++db)
#pragma unroll
              for (int ks = 0; ks < 8; ++ks) af[db][ks] = *(const bf16x8*)(wg + db * 32 * 128 + ks * 16); }
        const float* psc = pool_scale + g * 128 + dhalf * 64 + 4 * hh;
        float4 scv[2][4];
#pragma unroll
        for (int db = 0; db < 2; ++db)
#pragma unroll
            for (int q = 0; q < 4; ++q) scv[db][q] = *(const float4*)(psc + db * 32 + 8 * q);
        u32x4 greg[4];
#pragma unroll
        for (int i = 0; i < 4; ++i) { const int e = tid + 512 * i; greg[i] = *(const u32x4*)(proj + (size_t)(t0 + (e >> 4)) * DIN + C_CG + g * 128 + (e & 15) * 8); }
        if (g + 1 < 4) PL_ISSUE(g + 1);
        {
            const int cc = tid & 15, tb = (tid >> 4) * 4;
            const ATT_LAS u32x4* raw = (const ATT_LAS u32x4*)(lds + RAW) + cc;
            float s[8];
#pragma unroll
            for (int j = 0; j < 8; ++j) s[j] = 0.f;
#define PL_ACC(SGN, row) do { const u32x4 v_ = raw[(row) * 16]; _Pragma("unroll") for (int j_ = 0; j_ < 4; ++j_) { s[2 * j_] += SGN __uint_as_float(v_[j_] << 16); s[2 * j_ + 1] += SGN __uint_as_float(v_[j_] & 0xffff0000u); } } while (0)
            for (int p = tb - w2; p < tb + w2; ++p) PL_ACC(+, p + 8);
#pragma unroll
            for (int tt = 0; tt < 4; ++tt) {
                const int t = tb + tt, pos = pos0 + t;
                int lo = pos - w2; if (lo < 0) lo = 0; int hi = pos + w2; if (hi > SEQ) hi = SEQ;
                const float inv = 1.f / (float)(hi - lo);
                const u32x4 cur = raw[(t + 8) * 16]; u32x4 w;
#pragma unroll
                for (int j = 0; j < 4; ++j) w[j] = cvtpk(s[2 * j] * inv - __uint_as_float(cur[j] << 16), s[2 * j + 1] * inv - __uint_as_float(cur[j] & 0xffff0000u));
                *(ATT_LAS u32x4*)(lds + PL + t * 256 + ((cc ^ (t & 15)) * 16)) = w;
                if (tt < 3) { PL_ACC(+, t + w2 + 8); PL_ACC(-, t - w2 + 8); }
            }
#undef PL_ACC
        }
        __syncthreads();
        if (g + 1 < 4) PL_COMMIT();
#pragma unroll
        for (int i = 0; i < 4; ++i) { const int e = tid + 512 * i; const ldsp gd = lds + GT + (e >> 4) * RS + (e & 15) * 16; *(ATT_LAS u32x2*)gd = (u32x2){greg[i][0], greg[i][1]}; *(ATT_LAS u32x2*)(gd + 8) = (u32x2){greg[i][2], greg[i][3]}; }
        f32x16 acc[2];
#pragma unroll
        for (int db = 0; db < 2; ++db)
#pragma unroll
            for (int i = 0; i < 16; ++i) acc[db][i] = 0.f;
#pragma unroll
        for (int ks = 0; ks < 8; ++ks) {
            const bf16x8 bfrag = *(const ATT_LAS bf16x8*)(lds + PL + tok * 256 + (((2 * ks + hh) ^ (tok & 15)) * 16));
#pragma unroll
            for (int db = 0; db < 2; ++db) acc[db] = ATT_MFMA(af[db][ks], bfrag, acc[db]);
        }
        __syncthreads();
        {
            const ldsp gl = lds + GT + tok * RS + (dhalf * 64 + 4 * hh) * 2, ol = lds + OT + tok * RS + (dhalf * 64 + 4 * hh) * 2;
#pragma unroll
            for (int db = 0; db < 2; ++db)
#pragma unroll
                for (int q = 0; q < 4; ++q) {
                    const u32x2 gq = *(const ATT_LAS u32x2*)(gl + (db * 32 + 8 * q) * 2); const float4 sc = scv[db][q];
                    const float g0 = __uint_as_float(gq.x << 16), g1 = __uint_as_float(gq.x & 0xffff0000u), g2 = __uint_as_float(gq.y << 16), g3 = __uint_as_float(gq.y & 0xffff0000u);
                    u32x2 w; w.x = pk2(acc[db][4 * q] * sc.x * g0, acc[db][4 * q + 1] * sc.y * g1); w.y = pk2(acc[db][4 * q + 2] * sc.z * g2, acc[db][4 * q + 3] * sc.w * g3);
                    *(ATT_LAS u32x2*)(ol + (db * 32 + 8 * q) * 2) = w;
                }
        }
        __syncthreads();
#pragma unroll
        for (int i = 0; i < 4; ++i) { const int e = tid + 512 * i; const ldsp od = lds + OT + (e >> 4) * RS + (e & 15) * 16; const u32x2 a0 = *(const ATT_LAS u32x2*)od, a1 = *(const ATT_LAS u32x2*)(od + 8);
            *(u32x4*)(mixed + (size_t)(t0 + (e >> 4)) * DMIX + 1024 + g * 128 + (e & 15) * 8) = (u32x4){a0.x, a0.y, a1.x, a1.y}; }
    }
#undef PL_ISSUE
#undef PL_COMMIT
}
}

__global__ void __launch_bounds__(NT, 2) mega(Params P) {
    extern __shared__ __attribute__((aligned(16))) unsigned char lds_raw[];
    float* lds = (float*)lds_raw;
    PG8_LAS unsigned char* lds3 = (PG8_LAS unsigned char*)lds_raw;
    cg::grid_group grid = cg::this_grid();
    unsigned char* ws = P.ws;
    float* biastbl = (float*)(ws + WS_BIAS);
    bf16_t* proj = (bf16_t*)(ws + WS_PROJ); bf16_t* mixed = (bf16_t*)(ws + WS_MIX); bf16_t* xb = (bf16_t*)(ws + WS_XB);
    volatile LAS unsigned* bst = (volatile LAS unsigned*)(lds3 + (LDS_BYTES - 64));
    if (threadIdx.x == 0) { bst[0] = 0u; bst[1] = 0u; }
    __syncthreads();
    const XcdBarrier bar = xcd_barrier_post((unsigned*)ws, bst);
    ph_prologue(P, lds);
    if (P.use_cg_sync) grid.sync();
    xcd_barrier(bar);
    for (int l = 0; l < 2; ++l) {
        {
            pg8::Gemm g{xb, (const bf16_t*)(ws + WS_WIN) + (size_t)l * DIN * DM, T, DIN, DM};
            pg8::StaticOrder S; S.init(T, DIN, (int)gridDim.x, (int)blockIdx.x, WGM_P1);
            EpiProj E{proj, (const float*)(ws + (l == 0 ? WS_RSS0 : WS_RSS1)), (const float2*)(ws + WS_ROT), lds3 + 131072 + 8192};
            pg8::gemm_phase<EpiProj, pg8::StaticOrder, true, true>(lds3, g, S, E);
        }
        xcd_barrier(bar);
        {
            unsigned* cst = (unsigned*)(ws + WS_CNT) + l * 64;
            const att::ldsp ldsa = (att::ldsp)lds_raw;
            const int bid = (int)blockIdx.x, G = (int)gridDim.x;
            for (int it = bid; it < 256; it += G) ret::ret_state_item(ldsa, it, proj, P.decay + l * 8, (bf16_t*)(ws + ret::WS_RST), cst);
            const int rho = G == 256 ? ((bid & 7) * 2 + (bid >> 7)) % 5 : 4;
            att::attn_phase(ldsa, 0, rho, proj, biastbl, P.diff_lambda + l * 256, l, P.subln + l * 128, mixed);
            __syncthreads();
            if (G == 256) ret::ret_wait_states(cst, bid >> 4 & 3 | (bid >> 6) << 2, 16, 4); else ret::ret_wait_states(cst, 0, 1, 64);
            ret::ret_out_run(ldsa, bid, G, 1024, proj, P.decay + l * 8, (const bf16_t*)(ws + ret::WS_RST), mixed);
            __syncthreads();
            for (int it = bid; it < 256; it += G) pool::pool_item(ldsa, it, proj, (const bf16_t*)(ws + pool::WS_PW) + (size_t)l * 4 * 128 * 128, P.pool_scale + l * 512, mixed);
            __syncthreads();
            att::attn_phase(ldsa, rho, 4, proj, biastbl, P.diff_lambda + l * 256, l, P.subln + l * 128, mixed);
            __syncthreads();
        }
        xcd_barrier(bar);
        {
            pg8::Gemm g{mixed, (const bf16_t*)(ws + WS_WOUT) + (size_t)l * DM * DMIX, T, DM, DMIX};
            pg8::StaticOrder S; S.init(T, DM, (int)gridDim.x, (int)blockIdx.x);
            if (l == 0) { EpiOut<0> E{P.out, xb, (float*)(ws + WS_RSS1), lds3 + 131072 + 8192}; pg8::gemm_phase<EpiOut<0>, pg8::StaticOrder, true, true>(lds3, g, S, E); }
            else if (gridDim.x == 256) { EpiOutFinal E{P.out, xb, P.fnw, (float*)(ws + WS_SLOT), (unsigned*)(ws + WS_PCNT), lds3 + 131072, lds3 + 131072 + 8192}; pg8::gemm_phase<EpiOutFinal, pg8::StaticOrder, true, true>(lds3, g, S, E); }
            else { EpiOut<1> E{P.out, xb, (float*)(ws + WS_RSS1), lds3 + 131072 + 8192}; pg8::gemm_phase<EpiOut<1>, pg8::StaticOrder, true, true>(lds3, g, S, E); }
        }
        if (l == 0 || gridDim.x != 256) xcd_barrier(bar);
    }
    if (gridDim.x != 256) ph_final_norm(P.out, P.fnw);
}

extern "C" void kernel_launch(void* const* d_in, const int* in_sizes, int n_in, void* d_out, int out_size, void* d_ws, size_t ws_size, hipStream_t stream) {
    static int grid_blocks = 0;
    if (!grid_blocks) {
        int dev = 0, cus = 0, per_cu = 0;
        (void)hipGetDevice(&dev);
        (void)hipDeviceGetAttribute(&cus, hipDeviceAttributeMultiprocessorCount, dev);
        (void)hipFuncSetAttribute((const void*)mega, hipFuncAttributeMaxDynamicSharedMemorySize, LDS_BYTES);
        (void)hipOccupancyMaxActiveBlocksPerMultiprocessor(&per_cu, (const void*)mega, NT, LDS_BYTES);
        if (per_cu < 1) per_cu = 1;
        grid_blocks = 256;
        if (cus * per_cu < 256) fprintf(stderr, "kernel_launch: device capacity %d x %d < 256 workgroups: the cooperative launch will be rejected\n", cus, per_cu);
    }
    Params p{};
    p.x = (const float*)d_in[0]; p.norm_w = (const float*)d_in[1]; p.w_in = (const float*)d_in[2]; p.diff_lambda = (const float*)d_in[3];
    p.subln = (const float*)d_in[4]; p.decay = (const float*)d_in[5]; p.pool_w = (const float*)d_in[6]; p.pool_scale = (const float*)d_in[7];
    p.w_out = (const float*)d_in[8]; p.rel_bias = (const float*)d_in[9]; p.fnw = (const float*)d_in[10];
    p.out = (float*)d_out; p.ws = (unsigned char*)d_ws;
    (void)hipMemsetAsync(d_ws, 0, 65536, stream);
    void* args[] = {&p};
    hipError_t e = hipLaunchCooperativeKernel((const void*)mega, dim3(grid_blocks), dim3(NT), args, LDS_BYTES, stream);
    if (e != hipSuccess) fprintf(stderr, "cooperative launch failed: %s (grid %d)\n", hipGetErrorString(e), grid_blocks);
}
```

```cpp
#include <hip/hip_runtime.h>
#include <hip/hip_cooperative_groups.h>
#include <cstdint>
#include <cstdio>
namespace cg = cooperative_groups;

constexpr int BATCH = 16, SEQ = 2048, DM = 1024, T = BATCH * SEQ;
constexpr int DIN = 4608, DMIX = 1536;
constexpr int C_AQ = 0, C_AK = 512, C_AV = 1024, C_AG = 1536, C_BQ = 2048, C_BK = 2304, C_BV = 2560, C_BG = 3072, C_CU = 3584, C_CG = 4096;
constexpr float EPS = 1e-6f;
constexpr int WGM_P1 = 4;
constexpr int NT = 512;
constexpr int LDS_BYTES = 163840;

typedef unsigned short bf16_t;
__device__ __forceinline__ bf16_t f2bf(float f) { unsigned u = __float_as_uint(f); u += 0x7fffu + ((u >> 16) & 1u); return (bf16_t)(u >> 16); }
__device__ __forceinline__ float bf2f(bf16_t b) { return __uint_as_float(((unsigned)b) << 16); }
__device__ __forceinline__ float bfr(float f) { return bf2f(f2bf(f)); }
__device__ __forceinline__ float silu(float v) { return v * __builtin_amdgcn_rcpf(1.f + __builtin_amdgcn_exp2f(v * -1.4426950408889634f)); }
__device__ __forceinline__ unsigned pk2(float lo, float hi) { return (unsigned)f2bf(lo) | ((unsigned)f2bf(hi) << 16); }

constexpr size_t MiB = 1u << 20;
constexpr size_t WS_CONST = 768 * 1024;
constexpr size_t WS_CNT = 49152;
constexpr size_t WS_PCNT = 16384;
constexpr size_t WS_SLOT = 1 * MiB + 131072;
constexpr size_t WS_BIAS = 1 * MiB;
constexpr size_t WS_RSS0 = 2 * MiB;
constexpr size_t WS_RSS1 = 2 * MiB + 512 * 1024;
constexpr size_t WS_ROT = 3 * MiB;
constexpr size_t WS_WIN = 4 * MiB;
constexpr size_t WS_WOUT = 22 * MiB;
constexpr size_t WS_XB = 32 * MiB;
constexpr size_t WS_PROJ = 96 * MiB;
constexpr size_t WS_MIX = 384 * MiB;

struct Params {
    const float *x, *norm_w, *w_in, *diff_lambda, *subln, *decay, *pool_w, *pool_scale, *w_out, *rel_bias, *fnw;
    float* out; unsigned char* ws; int use_cg_sync; int pad_;
};
__device__ __forceinline__ void dma16(const void* base, unsigned voff, unsigned ldsaddr) {
    asm volatile("s_mov_b32 m0, %2\n\ts_nop 0\n\tglobal_load_lds_dwordx4 %0, %1" :: "v"(voff), "s"(base), "s"(ldsaddr) : "memory", "m0");
}

#define LAS __attribute__((address_space(3)))
#define XB_TMO      128
#define XB_XCNT(j)  (256  + 64 * (j))
#define XB_XSUB(j)  (1280 + 64 * (j))
#define XB_XGEN(j)  (2304 + 64 * (j))
#define XB_TOP      3328
#define XB_TOPGEN   3392
#define XCD_BAR_WORDS 3456
#define XB_SPIN_CAP (1u << 18)

__device__ __forceinline__ unsigned xb_ld(unsigned* p)              { return __hip_atomic_load(p, __ATOMIC_RELAXED, __HIP_MEMORY_SCOPE_AGENT); }
__device__ __forceinline__ unsigned xb_add(unsigned* p, unsigned v) { return __hip_atomic_fetch_add(p, v, __ATOMIC_RELAXED, __HIP_MEMORY_SCOPE_AGENT); }
__device__ __forceinline__ unsigned xb_xcc_id() { return (unsigned)__builtin_amdgcn_s_getreg((3 << 11) | 20) & 0xFu; }
#define XB_SPIN(cond, bar) do { unsigned _sp = 0; while (cond) { __builtin_amdgcn_s_sleep(1); \
    if ((++_sp & 255u) == 0u) { if (xb_ld(&(bar)[XB_TMO])) break; if (_sp > XB_SPIN_CAP) { atomicAdd(&(bar)[XB_TMO], 1u); break; } } } } while (0)

struct XcdBarrier {
    unsigned* bar; unsigned x;
    volatile LAS unsigned* st;
};

__device__ __forceinline__ XcdBarrier xcd_barrier_post(unsigned* bar, volatile LAS unsigned* st) {
    XcdBarrier b; b.bar = bar; b.x = xb_xcc_id(); b.st = st;
    if (threadIdx.x == 0) (void)xb_add(&bar[XB_XCNT(b.x)], 1u);
    return b;
}
__device__ __forceinline__ void xcd_barrier_complete(unsigned* bar, unsigned x, unsigned& nloc, unsigned& nx) {
    const unsigned G = gridDim.x * gridDim.y * gridDim.z;
    unsigned sum, cnt, mine, sp = 0u;
    for (;;) {
        sum = 0u; cnt = 0u; mine = 0u;
#pragma unroll
        for (unsigned j = 0; j < 16; ++j) { const unsigned c = xb_ld(&bar[XB_XCNT(j)]); sum += c; cnt += (c > 0u) ? 1u : 0u; mine = (j == x) ? c : mine; }
        if (sum == G) break;
        __builtin_amdgcn_s_sleep(1);
        if ((++sp & 255u) == 0u) { if (xb_ld(&bar[XB_TMO])) break; if (sp > XB_SPIN_CAP) { atomicAdd(&bar[XB_TMO], 1u); break; } }
    }
    nloc = mine > 0u ? mine : 1u; nx = cnt > 0u ? cnt : 1u;
}

__device__ __forceinline__ void xcd_barrier(const XcdBarrier& b) {
    asm volatile("s_waitcnt vmcnt(0)" ::: "memory");
    __syncthreads();
    if (threadIdx.x == 0) {
        unsigned* bar = b.bar;
        unsigned bx_ = b.x; asm volatile("" : "+s"(bx_));
        __builtin_amdgcn_s_waitcnt(0);
        unsigned nloc = b.st[0], nx = b.st[1];
        if (nloc == 0u) { xcd_barrier_complete(bar, bx_, nloc, nx); b.st[0] = nloc; b.st[1] = nx; }
        const unsigned old = xb_add(&bar[XB_XSUB(bx_)], 1u);
        const unsigned gen = old / nloc;
        if (old + 1u == (gen + 1u) * nloc) {
            __builtin_amdgcn_fence(__ATOMIC_RELEASE, "agent");
            asm volatile("s_waitcnt vmcnt(0)" ::: "memory");
            const unsigned og = xb_add(&bar[XB_TOP], 1u);
            const unsigned tg = og / nx;
            if (og + 1u == (tg + 1u) * nx) xb_add(&bar[XB_TOPGEN], 1u);
            else XB_SPIN(xb_ld(&bar[XB_TOPGEN]) == tg, bar);
            __builtin_amdgcn_fence(__ATOMIC_ACQUIRE, "agent");
            xb_add(&bar[XB_XGEN(bx_)], 1u);
            asm volatile("s_waitcnt vmcnt(0)" ::: "memory");
        } else {
            XB_SPIN(xb_ld(&bar[XB_XGEN(bx_)]) == gen, bar);
            __builtin_amdgcn_fence(__ATOMIC_ACQUIRE, "agent");
            asm volatile("s_waitcnt vmcnt(0)" ::: "memory");
        }
    }
    __syncthreads();
}

namespace pg8 {
#define PG8_LAS __attribute__((address_space(3)))
typedef unsigned short bf16_t;
typedef short bf16x8 __attribute__((ext_vector_type(8)));
typedef float f32x4 __attribute__((ext_vector_type(4)));
typedef unsigned u32x4 __attribute__((ext_vector_type(4)));
constexpr int BM = 256, BK = 64, HALF = 128, HTB = HALF * BK * 2  , STAGE_BYTES = 8 * HTB, NXCD = 8, WGM = 8;

__host__ __device__ __forceinline__ int lds_byte(int r, int c) { const int st = (r >> 4) * 2 + (c >> 5), rr = r & 15, cc = c & 31, ob = rr * 64 + cc * 2; return st * 1024 + (ob ^ (((ob >> 9) & 1) << 5)); }
__host__ __device__ __forceinline__ void stage_rc(int b, int& R, int& C) { const int st = b / 1024, sb = b % 1024, swz = sb ^ (((sb >> 9) & 1) << 5); R = (st >> 1) * 16 + swz / 64; C = (st & 1) * 32 + (swz % 64) / 2; }
__host__ __device__ __forceinline__ int perm32(int rho) { const int n = rho >> 4, i = rho & 15; return 8 * (i >> 2) + 4 * n + (i & 3); }

struct Unit { int pm, pn; };
struct Gemm { const bf16_t* A; const bf16_t* Bt; int M, N, K; };

struct StaticOrder {
    int nM, nN, nwg, G, c, wgm;
    __host__ __device__ void init(int M, int N, int G_, int c_, int wgm_ = WGM) { nM = M / BM; nN = N / BM; nwg = nM * nN; G = G_; c = c_; wgm = wgm_; }
    __host__ __device__ bool next(int i, Unit& u) const {
        const long L = (long)i * G + c; if (L >= nwg) return false;
        int wgid = (int)L; { const int q = nwg / NXCD, r = nwg % NXCD, xcd = wgid % NXCD, off = wgid / NXCD; wgid = (xcd < r ? xcd * (q + 1) : r * (q + 1) + (xcd - r) * q) + off; }
        const int nig = wgm * nN, gid = wgid / nig, fm = gid * wgm, gsz = (nM - fm) < wgm ? (nM - fm) : wgm;
        u.pm = fm + ((wgid % nig) % gsz); u.pn = (wgid % nig) / gsz; return true;
    }
    __device__ __forceinline__ void a_ready(const Unit&) const {}
    __device__ __forceinline__ void done(const Unit&) const {}
};


__device__ __forceinline__ unsigned cvt_pk_bf16(float lo, float hi) { unsigned r; asm volatile("v_cvt_pk_bf16_f32 %0, %1, %2" : "=v"(r) : "v"(lo), "v"(hi)); return r; }
typedef float f32x2 __attribute__((ext_vector_type(2)));

template <class Epi, class Sched, bool ALIGN_EPI = false, bool SP2 = false>
__device__ __forceinline__ void gemm_phase(PG8_LAS unsigned char* lds, const Gemm g, const Sched& S, const Epi& E) {
    int tid_ = threadIdx.x; asm volatile("" : "+v"(tid_)); const int tid = tid_, wid = __builtin_amdgcn_readfirstlane(tid >> 6), lane = tid & 63, wr = wid >> 2, wc = wid & 3, fr = lane & 15, fq = lane >> 4;
    const int K = g.K, nt = K / BK;
    unsigned voffA[2], voffB[2];
#pragma unroll
    for (int i = 0; i < 2; ++i) { int R, C; stage_rc(tid * 16 + i * 8192, R, C); const int Rb = Epi::PERM ? ((R & ~31) + perm32(R & 31)) : R;
        voffA[i] = (unsigned)(R * K + C) * 2u; voffB[i] = (unsigned)(Rb * K + C) * 2u; }
    const size_t kstep = (size_t)(BK * 2);
    const size_t hstep = (size_t)HALF * K * 2;
    const size_t tstep = 2 * hstep;
    const unsigned ldsw = (unsigned)wid * 1024u;
    const int aoff = lds_byte(wr * 64 + fr, fq * 8), boff = lds_byte(wc * 32 + fr, fq * 8);
#define PG8_SA(b, h) (((b) * 2 + (h)) * HTB)
#define PG8_SB(b, h) ((4 + (b) * 2 + (h)) * HTB)
#define PG8_STAGE(bufoff, gbase, voff) do { _Pragma("unroll") for (int _i = 0; _i < 2; ++_i) \
        dma16((gbase), (voff)[_i], (unsigned)(size_t)(lds + (bufoff) + ldsw + _i * 8192)); } while (0)
#define PG8_LDA(dst, b, h) do { _Pragma("unroll") for (int m = 0; m < 4; ++m) _Pragma("unroll") for (int k = 0; k < 2; ++k) dst[m][k] = *(const PG8_LAS bf16x8*)(lds + PG8_SA(b, h) + aoff + m * 2048 + k * 1024); } while (0)
#define PG8_LDB(dst, b, h) do { _Pragma("unroll") for (int n = 0; n < 2; ++n) _Pragma("unroll") for (int k = 0; k < 2; ++k) dst[n][k] = *(const PG8_LAS bf16x8*)(lds + PG8_SB(b, h) + boff + n * 2048 + k * 1024); } while (0)
#define PG8_MMA(ai, bj, At, Bt) do { __builtin_amdgcn_s_setprio(1); _Pragma("unroll") for (int m = 0; m < 4; ++m) _Pragma("unroll") for (int n = 0; n < 2; ++n) _Pragma("unroll") for (int k = 0; k < 2; ++k) \
        acc[ai][bj][m][n] = __builtin_amdgcn_mfma_f32_16x16x32_bf16(Bt[n][k], At[m][k], acc[ai][bj][m][n], 0, 0, 0); __builtin_amdgcn_s_setprio(0); } while (0)
#define PG8_WAIT_V(n) asm volatile("s_waitcnt vmcnt(" #n ")" ::: "memory")
#define PG8_WAIT_L(n) asm volatile("s_waitcnt lgkmcnt(" #n ")" ::: "memory")
#define PG8_BAR __builtin_amdgcn_s_barrier()
#define PG8_SCHED __builtin_amdgcn_sched_barrier(0)
    Unit cur, nxt; int ui = 0;
    if (!S.next(0, cur)) return;
    f32x4 acc[2][2][4][2];
#pragma unroll
    for (int a = 0; a < 2; ++a)
#pragma unroll
        for (int b = 0; b < 2; ++b)
#pragma unroll
            for (int m = 0; m < 4; ++m)
#pragma unroll
                for (int n = 0; n < 2; ++n) acc[a][b][m][n] = (f32x4){0.f, 0.f, 0.f, 0.f};
    bf16x8 At[4][2], B0[2][2], B1[2][2];
    const char* cA = (const char*)g.A + (size_t)cur.pm * tstep; const char* cB = (const char*)g.Bt + (size_t)cur.pn * tstep;
    S.a_ready(cur);
    if constexpr (SP2) {
        PG8_STAGE(PG8_SB(0, 0), cB, voffB); PG8_STAGE(PG8_SB(0, 1), cB + hstep, voffB); PG8_STAGE(PG8_SA(0, 0), cA, voffA); PG8_STAGE(PG8_SA(0, 1), cA + hstep, voffA);
        if (wr == 1) PG8_BAR;
        PG8_WAIT_V(2); PG8_BAR;
        PG8_STAGE(PG8_SB(1, 0), cB + kstep, voffB); PG8_STAGE(PG8_SA(1, 0), cA + kstep, voffA); PG8_STAGE(PG8_SB(1, 1), cB + hstep + kstep, voffB);
        PG8_WAIT_V(6); PG8_BAR;
    } else {
        PG8_STAGE(PG8_SB(0, 0), cB, voffB); PG8_STAGE(PG8_SA(0, 0), cA, voffA); PG8_STAGE(PG8_SB(0, 1), cB + hstep, voffB); PG8_STAGE(PG8_SA(0, 1), cA + hstep, voffA);
        if (wr == 1) PG8_BAR;
        PG8_WAIT_V(4); PG8_BAR;
        PG8_STAGE(PG8_SB(1, 0), cB + kstep, voffB); PG8_STAGE(PG8_SA(1, 0), cA + kstep, voffA); PG8_STAGE(PG8_SB(1, 1), cB + hstep + kstep, voffB);
        PG8_WAIT_V(6); PG8_BAR;
    }
    for (;;) {
        const bool has_next = S.next(ui + 1, nxt);
        const char* nA = has_next ? (const char*)g.A + (size_t)nxt.pm * tstep : cA; const char* nB = has_next ? (const char*)g.Bt + (size_t)nxt.pn * tstep : cB;
        for (int t = 0; t < nt; t += 2) {
            const bool last = (t == nt - 2);
            const char* a1 = cA + (size_t)(t + 1) * kstep;
            const char* a2 = last ? nA : cA + (size_t)(t + 2) * kstep; const char* b2 = last ? nB : cB + (size_t)(t + 2) * kstep;
            const char* a3 = a2 + kstep; const char* b3 = b2 + kstep;
            if (last && has_next) S.a_ready(nxt);
            if constexpr (SP2) {
            PG8_LDB(B0, 0, 0); PG8_LDB(B1, 0, 1); PG8_SCHED; PG8_LDA(At, 0, 0); PG8_STAGE(PG8_SA(1, 1), a1 + hstep, voffA);
            PG8_WAIT_V(8); PG8_WAIT_L(0); PG8_BAR; PG8_MMA(0, 0, At, B0); PG8_MMA(0, 1, At, B1); PG8_BAR; PG8_SCHED;
            PG8_LDA(At, 0, 1); PG8_STAGE(PG8_SB(0, 0), b2, voffB); PG8_STAGE(PG8_SB(0, 1), b2 + hstep, voffB); PG8_STAGE(PG8_SA(0, 0), a2, voffA);
            PG8_WAIT_V(8); PG8_WAIT_L(0); PG8_BAR; PG8_MMA(1, 0, At, B0); PG8_MMA(1, 1, At, B1); PG8_BAR; PG8_SCHED;
            PG8_LDB(B0, 1, 0); PG8_LDB(B1, 1, 1); PG8_SCHED; PG8_LDA(At, 1, 0); PG8_STAGE(PG8_SA(0, 1), a2 + hstep, voffA);
            PG8_WAIT_V(8); PG8_WAIT_L(0); PG8_BAR; PG8_MMA(0, 0, At, B0); PG8_MMA(0, 1, At, B1); PG8_BAR; PG8_SCHED;
            PG8_LDA(At, 1, 1); PG8_STAGE(PG8_SB(1, 0), b3, voffB); PG8_STAGE(PG8_SB(1, 1), b3 + hstep, voffB); PG8_STAGE(PG8_SA(1, 0), a3, voffA);
            PG8_WAIT_V(8); PG8_WAIT_L(0); PG8_BAR; PG8_MMA(1, 0, At, B0); PG8_MMA(1, 1, At, B1); PG8_BAR; PG8_SCHED;
            } else {
            PG8_LDB(B0, 0, 0); PG8_SCHED; PG8_LDA(At, 0, 0); PG8_STAGE(PG8_SA(1, 1), a1 + hstep, voffA);
            PG8_WAIT_L(8); PG8_BAR; PG8_WAIT_L(0); PG8_MMA(0, 0, At, B0); PG8_BAR; PG8_SCHED;
            PG8_LDB(B1, 0, 1); PG8_STAGE(PG8_SB(0, 0), b2, voffB);
            PG8_BAR; PG8_WAIT_L(0); PG8_MMA(0, 1, At, B1); PG8_BAR;
            PG8_LDA(At, 0, 1); PG8_STAGE(PG8_SA(0, 0), a2, voffA);
            PG8_BAR; PG8_WAIT_L(0); PG8_MMA(1, 0, At, B0); PG8_BAR; PG8_SCHED;
            PG8_STAGE(PG8_SB(0, 1), b2 + hstep, voffB);
            PG8_WAIT_V(6); PG8_BAR; PG8_MMA(1, 1, At, B1); PG8_BAR;
            PG8_LDB(B0, 1, 0); PG8_SCHED; PG8_LDA(At, 1, 0); PG8_STAGE(PG8_SA(0, 1), a2 + hstep, voffA);
            PG8_WAIT_L(8); PG8_BAR; PG8_WAIT_L(0); PG8_MMA(0, 0, At, B0); PG8_BAR; PG8_SCHED;
            PG8_LDB(B1, 1, 1); PG8_STAGE(PG8_SB(1, 0), b3, voffB);
            PG8_BAR; PG8_WAIT_L(0); PG8_MMA(0, 1, At, B1); PG8_BAR;
            PG8_LDA(At, 1, 1); PG8_STAGE(PG8_SA(1, 0), a3, voffA);
            PG8_BAR; PG8_WAIT_L(0); PG8_MMA(1, 0, At, B0); PG8_BAR; PG8_SCHED;
            PG8_STAGE(PG8_SB(1, 1), b3 + hstep, voffB);
            PG8_WAIT_V(6); PG8_BAR; PG8_MMA(1, 1, At, B1); PG8_BAR;
            }
        }
        if constexpr (ALIGN_EPI) { if (wr == 0) PG8_BAR; }
        if constexpr (!Epi::AFTER_DRAIN) { E(acc, cur, wr, wc, fr, fq); S.done(cur); }
        if (!has_next) break;
#pragma unroll
        for (int a = 0; a < 2; ++a)
#pragma unroll
            for (int b = 0; b < 2; ++b)
#pragma unroll
                for (int m = 0; m < 4; ++m)
#pragma unroll
                    for (int n = 0; n < 2; ++n) acc[a][b][m][n] = (f32x4){0.f, 0.f, 0.f, 0.f};
        cur = nxt; cA = nA; cB = nB; ++ui;
        if constexpr (ALIGN_EPI) { if (wr == 1) PG8_BAR; }
    }
    PG8_WAIT_V(0);
    if constexpr (!ALIGN_EPI) { if (wr == 0) PG8_BAR; }
    PG8_BAR;
    if constexpr (Epi::AFTER_DRAIN) { E.fused(acc, cur, wr, wc, fr, fq, lds, wid, lane); S.done(cur); }
#undef PG8_SA
#undef PG8_SB
#undef PG8_STAGE
#undef PG8_LDA
#undef PG8_LDB
#undef PG8_MMA
#undef PG8_WAIT_V
#undef PG8_WAIT_L
#undef PG8_BAR
#undef PG8_SCHED
}
}

template <int LD> __device__ __forceinline__ void epi_put16(const pg8::u32x4& wa, const pg8::u32x4& wb, bf16_t* gbase, PG8_LAS unsigned char* sc, int fr, int fq, int lane) {
    *(PG8_LAS pg8::u32x4*)(sc + fr * 128 + ((fq ^ (fr & 7)) * 16)) = wa;
    *(PG8_LAS pg8::u32x4*)(sc + fr * 128 + (((4 + fq) ^ (fr & 7)) * 16)) = wb;
    asm volatile("s_waitcnt lgkmcnt(0)" ::: "memory");
    const int rr = lane >> 3, c = lane & 7;
    const pg8::u32x4 x0 = *(const PG8_LAS pg8::u32x4*)(sc + rr * 128 + ((c ^ (rr & 7)) * 16)), x1 = *(const PG8_LAS pg8::u32x4*)(sc + (rr + 8) * 128 + ((c ^ (rr & 7)) * 16));
    asm volatile("s_waitcnt lgkmcnt(0)" ::: "memory");
    *(pg8::u32x4*)(gbase + (size_t)rr * LD + c * 8) = x0; *(pg8::u32x4*)(gbase + (size_t)(rr + 8) * LD + c * 8) = x1;
}
__device__ __forceinline__ void epi_put32(const pg8::f32x4& va, const pg8::f32x4& vb, float* gbase, PG8_LAS unsigned char* sc, int fr, int fq, int lane) {
    *(PG8_LAS pg8::f32x4*)(sc + fr * 128 + (((2 * fq) ^ (fr & 7)) * 16)) = va;
    *(PG8_LAS pg8::f32x4*)(sc + fr * 128 + (((2 * fq + 1) ^ (fr & 7)) * 16)) = vb;
    asm volatile("s_waitcnt lgkmcnt(0)" ::: "memory");
    const int rr = lane >> 3, c = lane & 7;
    const pg8::f32x4 x0 = *(const PG8_LAS pg8::f32x4*)(sc + rr * 128 + ((c ^ (rr & 7)) * 16)), x1 = *(const PG8_LAS pg8::f32x4*)(sc + (rr + 8) * 128 + ((c ^ (rr & 7)) * 16));
    asm volatile("s_waitcnt lgkmcnt(0)" ::: "memory");
    *(pg8::f32x4*)(gbase + (size_t)rr * DM + c * 4) = x0; *(pg8::f32x4*)(gbase + (size_t)(rr + 8) * DM + c * 4) = x1;
}
struct EpiProj {
    static constexpr bool PERM = true, AFTER_DRAIN = false;
    bf16_t* O; const float* rowss; const float2* rot; PG8_LAS unsigned char* xs;
    __device__ __forceinline__ void operator()(const pg8::f32x4 (&acc)[2][2][4][2], const pg8::Unit& u, int wr, int wc, int fr, int fq) const {
        const int lane = fq * 16 + fr;
        PG8_LAS unsigned char* sc = xs + (wr * 4 + wc) * 2048;
        const int rowb = u.pm * 256 + wr * 64, colb = u.pn * 256 + wc * 64;
        const bool rotary = (u.pn == 8 || u.pn == 9);
        const bool gatep = (u.pn == 6 || u.pn == 7 || u.pn == 12 || u.pn == 13 || u.pn == 16 || u.pn == 17);
        float rsv[8];
#pragma unroll
        for (int i = 0; i < 8; ++i) rsv[i] = rowss[rowb + (i >> 2) * 128 + (i & 3) * 16 + fr];
#pragma unroll
        for (int ai = 0; ai < 2; ++ai)
#pragma unroll
            for (int m = 0; m < 4; ++m) {
                const int row = rowb + ai * 128 + m * 16 + fr;
                const float rs = rsqrtf(rsv[ai * 4 + m] * (1.f / DM) + EPS);
                pg8::f32x4 a0 = acc[ai][0][m][0] * rs, a1 = acc[ai][0][m][1] * rs, b0 = acc[ai][1][m][0] * rs, b1 = acc[ai][1][m][1] * rs;
                if (gatep) {
#pragma unroll
                    for (int j = 0; j < 4; ++j) { a0[j] = silu(a0[j]); a1[j] = silu(a1[j]); b0[j] = silu(b0[j]); b1[j] = silu(b1[j]); }
                }
                pg8::u32x4 w1, w2;
                if (rotary) {
                    const pg8::f32x4* cs = (const pg8::f32x4*)(rot + (size_t)(row & (SEQ - 1)) * 32 + 8 * fq);
                    const pg8::f32x4 c01 = cs[0], c23 = cs[1], c45 = cs[2], c67 = cs[3];
                    w1.x = pg8::cvt_pk_bf16(a0[0] * c01[0] - b0[0] * c01[1], a0[1] * c01[2] - b0[1] * c01[3]); w2.x = pg8::cvt_pk_bf16(a0[0] * c01[1] + b0[0] * c01[0], a0[1] * c01[3] + b0[1] * c01[2]);
                    w1.y = pg8::cvt_pk_bf16(a0[2] * c23[0] - b0[2] * c23[1], a0[3] * c23[2] - b0[3] * c23[3]); w2.y = pg8::cvt_pk_bf16(a0[2] * c23[1] + b0[2] * c23[0], a0[3] * c23[3] + b0[3] * c23[2]);
                    w1.z = pg8::cvt_pk_bf16(a1[0] * c45[0] - b1[0] * c45[1], a1[1] * c45[2] - b1[1] * c45[3]); w2.z = pg8::cvt_pk_bf16(a1[0] * c45[1] + b1[0] * c45[0], a1[1] * c45[3] + b1[1] * c45[2]);
                    w1.w = pg8::cvt_pk_bf16(a1[2] * c67[0] - b1[2] * c67[1], a1[3] * c67[2] - b1[3] * c67[3]); w2.w = pg8::cvt_pk_bf16(a1[2] * c67[1] + b1[2] * c67[0], a1[3] * c67[3] + b1[3] * c67[2]);
                } else {
                    w1.x = pg8::cvt_pk_bf16(a0[0], a0[1]); w1.y = pg8::cvt_pk_bf16(a0[2], a0[3]); w1.z = pg8::cvt_pk_bf16(a1[0], a1[1]); w1.w = pg8::cvt_pk_bf16(a1[2], a1[3]);
                    w2.x = pg8::cvt_pk_bf16(b0[0], b0[1]); w2.y = pg8::cvt_pk_bf16(b0[2], b0[3]); w2.z = pg8::cvt_pk_bf16(b1[0], b1[1]); w2.w = pg8::cvt_pk_bf16(b1[2], b1[3]);
                }
                epi_put16<DIN>(w1, w2, O + (size_t)(rowb + ai * 128 + m * 16) * DIN + colb, sc, fr, fq, lane);
            }
    }
};
template <int MODE> struct EpiOut {
    static constexpr bool PERM = true, AFTER_DRAIN = false;
    float* out; bf16_t* xb; float* rss; PG8_LAS unsigned char* xs;
    __device__ __forceinline__ void operator()(const pg8::f32x4 (&acc)[2][2][4][2], const pg8::Unit& u, int wr, int wc, int fr, int fq) const {
        const int lane = fq * 16 + fr;
        PG8_LAS unsigned char* sc = xs + (wr * 4 + wc) * 2048;
        const int rowb = u.pm * 256 + wr * 64, colb = u.pn * 256 + wc * 64;
        pg8::u32x4 xrv[8][2];
#pragma unroll
        for (int i = 0; i < 8; ++i)
#pragma unroll
            for (int bj = 0; bj < 2; ++bj) xrv[i][bj] = *(const pg8::u32x4*)(xb + (size_t)(rowb + (i >> 2) * 128 + (i & 3) * 16 + fr) * DM + colb + 8 * fq + bj * 32);
#pragma unroll
        for (int ai = 0; ai < 2; ++ai)
#pragma unroll
            for (int m = 0; m < 4; ++m) {
                const int row = rowb + ai * 128 + m * 16 + fr;
                float ss = 0.f; pg8::u32x4 w[2]; pg8::f32x4 v[2][2];
#pragma unroll
                for (int bj = 0; bj < 2; ++bj) {
                    const pg8::u32x4 xr = xrv[ai * 4 + m][bj];
                    pg8::f32x4 v0 = acc[ai][bj][m][0], v1 = acc[ai][bj][m][1];
                    v0[0] += __uint_as_float(xr.x << 16); v0[1] += __uint_as_float(xr.x & 0xffff0000u); v0[2] += __uint_as_float(xr.y << 16); v0[3] += __uint_as_float(xr.y & 0xffff0000u);
                    v1[0] += __uint_as_float(xr.z << 16); v1[1] += __uint_as_float(xr.z & 0xffff0000u); v1[2] += __uint_as_float(xr.w << 16); v1[3] += __uint_as_float(xr.w & 0xffff0000u);
                    v[bj][0] = v0; v[bj][1] = v1;
                    if (MODE == 0) {
                        w[bj].x = pg8::cvt_pk_bf16(v0[0], v0[1]); w[bj].y = pg8::cvt_pk_bf16(v0[2], v0[3]); w[bj].z = pg8::cvt_pk_bf16(v1[0], v1[1]); w[bj].w = pg8::cvt_pk_bf16(v1[2], v1[3]);
                        const float r0 = __uint_as_float(w[bj].x << 16), r1 = __uint_as_float(w[bj].x & 0xffff0000u), r2 = __uint_as_float(w[bj].y << 16), r3 = __uint_as_float(w[bj].y & 0xffff0000u);
                        const float r4 = __uint_as_float(w[bj].z << 16), r5 = __uint_as_float(w[bj].z & 0xffff0000u), r6 = __uint_as_float(w[bj].w << 16), r7 = __uint_as_float(w[bj].w & 0xffff0000u);
                        ss += (r0 * r0 + r1 * r1) + (r2 * r2 + r3 * r3) + (r4 * r4 + r5 * r5) + (r6 * r6 + r7 * r7);
                    }
                }
                if (MODE == 0) {
                    epi_put16<DM>(w[0], w[1], xb + (size_t)(rowb + ai * 128 + m * 16) * DM + colb, sc, fr, fq, lane);
                    ss += __shfl_xor(ss, 16); ss += __shfl_xor(ss, 32); if (fq == 0) atomicAdd(rss + row, ss);
                } else {
#pragma unroll
                    for (int bj = 0; bj < 2; ++bj) epi_put32(v[bj][0], v[bj][1], out + (size_t)(rowb + ai * 128 + m * 16) * DM + colb + bj * 32, sc, fr, fq, lane);
                }
            }
    }
};
struct EpiOutFinal {
    static constexpr bool PERM = true, AFTER_DRAIN = false;
    float* out; const bf16_t* xb; const float* fnw; float* slots; unsigned* cnt; PG8_LAS unsigned char* xl; PG8_LAS unsigned char* xs;
    __device__ __forceinline__ void operator()(const pg8::f32x4 (&acc_)[2][2][4][2], const pg8::Unit& u, int wr, int wc, int fr, int fq) const {
        pg8::f32x4 (&acc)[2][2][4][2] = const_cast<pg8::f32x4 (&)[2][2][4][2]>(acc_);
        int tid_ = threadIdx.x; asm volatile("" : "+v"(tid_));
        const int tid = tid_, lane = tid & 63, wid = __builtin_amdgcn_readfirstlane(tid >> 6);
        PG8_LAS float* Pl = (PG8_LAS float*)xl; PG8_LAS float* Sl = (PG8_LAS float*)(xl + 4096); PG8_LAS unsigned* flag = (PG8_LAS unsigned*)(xl + 5120);
        const int row0 = u.pm * 256 + wr * 64 + fr, col0 = u.pn * 256 + wc * 64 + 8 * fq;
        PG8_LAS unsigned char* sc = xs + (wr * 4 + wc) * 2048;
#pragma unroll
        for (int ai = 0; ai < 2; ++ai)
#pragma unroll
            for (int m = 0; m < 4; ++m) {
                const size_t off = (size_t)(row0 + ai * 128 + m * 16) * DM + col0;
                float ss = 0.f;
#pragma unroll
                for (int bj = 0; bj < 2; ++bj) {
                    const pg8::u32x4 xr = *(const pg8::u32x4*)(xb + off + bj * 32);
                    pg8::f32x4& v0 = acc[ai][bj][m][0]; pg8::f32x4& v1 = acc[ai][bj][m][1];
                    v0[0] += __uint_as_float(xr.x << 16); v0[1] += __uint_as_float(xr.x & 0xffff0000u); v0[2] += __uint_as_float(xr.y << 16); v0[3] += __uint_as_float(xr.y & 0xffff0000u);
                    v1[0] += __uint_as_float(xr.z << 16); v1[1] += __uint_as_float(xr.z & 0xffff0000u); v1[2] += __uint_as_float(xr.w << 16); v1[3] += __uint_as_float(xr.w & 0xffff0000u);
                    ss += (v0[0] * v0[0] + v0[1] * v0[1]) + (v0[2] * v0[2] + v0[3] * v0[3]) + (v1[0] * v1[0] + v1[1] * v1[1]) + (v1[2] * v1[2] + v1[3] * v1[3]);
                }
                ss += __shfl_xor(ss, 16); ss += __shfl_xor(ss, 32);
                if (fq == 0) Pl[(ai * 128 + wr * 64 + m * 16 + fr) * 4 + wc] = ss;
            }
        asm volatile("s_waitcnt lgkmcnt(0)\n\ts_barrier" ::: "memory");
        if (tid < 256) {
            const float s = (Pl[tid * 4] + Pl[tid * 4 + 1]) + (Pl[tid * 4 + 2] + Pl[tid * 4 + 3]);
            __hip_atomic_store(slots + ((size_t)(u.pm * 256 + tid) * 4 + u.pn), s, __ATOMIC_RELAXED, __HIP_MEMORY_SCOPE_AGENT);
        }
        asm volatile("s_waitcnt vmcnt(0)" ::: "memory");
        if (lane == 0) __hip_atomic_fetch_add(cnt + 64 * u.pm, 1u, __ATOMIC_RELAXED, __HIP_MEMORY_SCOPE_AGENT);
        if (wid == 0) {
            unsigned sp = 0;
            while ((unsigned)__builtin_amdgcn_readfirstlane(__hip_atomic_load(cnt + 64 * u.pm, __ATOMIC_RELAXED, __HIP_MEMORY_SCOPE_AGENT)) < 32u && ++sp < (1u << 22)) __builtin_amdgcn_s_sleep(1);
            __builtin_amdgcn_fence(__ATOMIC_ACQUIRE, "agent");
            if (lane == 0) flag[0] = sp;
        }
        asm volatile("s_waitcnt vmcnt(0) lgkmcnt(0)\n\ts_barrier" ::: "memory");
        if (tid < 256) {
            const float* sl = slots + (size_t)(u.pm * 256 + tid) * 4; float t = 0.f;
#pragma unroll
            for (int k = 0; k < 4; ++k) t += __hip_atomic_load(sl + k, __ATOMIC_RELAXED, __HIP_MEMORY_SCOPE_AGENT);
            Sl[tid] = rsqrtf(t * (1.f / DM) + EPS);
        }
        asm volatile("s_waitcnt vmcnt(0) lgkmcnt(0)\n\ts_barrier" ::: "memory");
        pg8::f32x4 w0[2], w1[2];
#pragma unroll
        for (int bj = 0; bj < 2; ++bj) { w0[bj] = *(const pg8::f32x4*)(fnw + col0 + bj * 32); w1[bj] = *(const pg8::f32x4*)(fnw + col0 + bj * 32 + 4); }
        const int lane_ = fq * 16 + fr;
#pragma unroll
        for (int ai = 0; ai < 2; ++ai)
#pragma unroll
            for (int m = 0; m < 4; ++m) {
                const int rl = ai * 128 + wr * 64 + m * 16 + fr; const float rs = Sl[rl];
#pragma unroll
                for (int bj = 0; bj < 2; ++bj)
                    epi_put32(acc[ai][bj][m][0] * rs * w0[bj], acc[ai][bj][m][1] * rs * w1[bj], out + (size_t)(u.pm * 256 + ai * 128 + wr * 64 + m * 16) * DM + u.pn * 256 + wc * 64 + bj * 32, sc, fr, fq, lane_);
            }
    }
};

__device__ __forceinline__ void ph_bias_table(const float* rel_bias, float* tbl, int gtid, int gsize) {
    for (int i = gtid; i < 4096; i += gsize) {
        int rel = i - 2048;
        int ret = rel > 0 ? 16 : 0;
        int n = rel < 0 ? -rel : rel;
        float nf = (float)(n > 1 ? n : 1);
        float lg = logf(nf / 8.0f) / 2.7725887298583984f * 8.0f;
        int large = 8 + (int)lg;
        if (large > 15) large = 15;
        int b = ret + (n < 8 ? n : large);
        for (int h = 0; h < 4; ++h) tbl[h * 4096 + i] = rel_bias[b * 4 + h] * 1.4426950408889634f;
    }
}
__device__ __forceinline__ void p0_transpose_item(const float* W, const float* sc, int K, int N, bf16_t* WT, LAS float* scr, int item, int lane, int nlim, float nscale, bool perm) {
    const int nblk = N / 32, kb = item / nblk, nb = item % nblk, k0 = 64 * kb, n0 = 32 * nb; const float ns = n0 < nlim ? nscale : 1.f;
    int n0o = n0; if (perm) { const int tb = n0 & ~255, rel = n0 & 255; n0o = tb + ((rel >> 5) & 1) * 128 + (rel >> 6) * 32; }
    float v[32];
#pragma unroll
    for (int i = 0; i < 32; ++i) v[i] = W[(size_t)(k0 + 2 * i + (lane >> 5)) * N + n0 + (lane & 31)];
    if (sc) {
#pragma unroll
        for (int i = 0; i < 32; ++i) v[i] *= sc[k0 + 2 * i + (lane >> 5)] * ns;
    }
#pragma unroll
    for (int i = 0; i < 32; ++i) scr[(2 * i + (lane >> 5)) * 33 + (lane & 31)] = v[i];
    asm volatile("s_waitcnt lgkmcnt(0)" ::: "memory");
    const int c = lane & 7;
#pragma unroll
    for (int j = 0; j < 4; ++j) { const int n = (lane >> 3) + 8 * j; const LAS float* s = scr + (8 * c) * 33 + n;
        uint4 o; o.x = pk2(s[0 * 33], s[1 * 33]); o.y = pk2(s[2 * 33], s[3 * 33]); o.z = pk2(s[4 * 33], s[5 * 33]); o.w = pk2(s[6 * 33], s[7 * 33]);
        *(uint4*)(WT + (size_t)(n0o + n) * K + k0 + 8 * c) = o; }
    asm volatile("s_waitcnt lgkmcnt(0)" ::: "memory");
}
__device__ __forceinline__ void ph_prologue(const Params& P, float* lds) {
    unsigned char* ws = P.ws;
    int tid_ = threadIdx.x; asm volatile("" : "+v"(tid_));
    const int lane = tid_ & 63, wave = tid_ >> 6;
    const int gw = blockIdx.x * (NT / 64) + wave, ngw = gridDim.x * (NT / 64);
    if (blockIdx.x == 0 && tid_ < 18) {
        float* ct = (float*)(ws + WS_CONST);
        if (tid_ < 16) ct[tid_] = -log1pf(expf(-P.decay[tid_])) * 1.4426950408889634f;
        else { const int l = tid_ - 16; const float* dl = P.diff_lambda + l * 256; float s01 = 0.f, s23 = 0.f;
            for (int d = 0; d < 64; ++d) { s01 += dl[d] * dl[64 + d]; s23 += dl[128 + d] * dl[192 + d]; }
            ct[16 + l] = expf(s01) - expf(s23) + (l == 0 ? 0.2f : 0.35550907f); }
    }
    ph_bias_table(P.rel_bias, (float*)(ws + WS_BIAS), blockIdx.x * NT + tid_, gridDim.x * NT);
    {
        float2* rot = (float2*)(ws + WS_ROT);
        for (int i = blockIdx.x * NT + tid_; i < SEQ * 32; i += gridDim.x * NT) {
            const int pr = i & 31, pos = i >> 5;
            const float theta = 1.0f / powf(10000.0f, (float)pr / 31.0f);
            const float ang = (float)pos * theta;
            rot[i] = make_float2(cosf(ang), sinf(ang));
        }
    }
    LAS float* scr = (LAS float*)lds + wave * (64 * 33);
    constexpr int I_IN = (DM / 64) * (DIN / 32), I_OUT = (DMIX / 64) * (DM / 32);
    constexpr int I_PW = (128 / 64) * (128 / 32);
    for (int it = gw; it < 8 * I_PW; it += ngw) { const int mtx = it / I_PW; p0_transpose_item(P.pool_w + (size_t)mtx * 128 * 128, nullptr, 128, 128, (bf16_t*)(ws + (28u << 20)) + (size_t)mtx * 128 * 128, scr, it % I_PW, lane, 0, 1.f, false); }
    for (int it = gw; it < 2 * (I_IN + I_OUT); it += ngw) {
        int r = it;
        if (r < 2 * I_IN) { const int l = r / I_IN; r -= l * I_IN; p0_transpose_item(P.w_in + (size_t)l * DM * DIN, P.norm_w + l * DM, DM, DIN, (bf16_t*)(ws + WS_WIN) + (size_t)l * DIN * DM, scr, r, lane, 512, 0.125f * 1.4426950408889634f, true); }
        else { r -= 2 * I_IN; const int l = r / I_OUT; r -= l * I_OUT; p0_transpose_item(P.w_out + (size_t)l * DMIX * DM, nullptr, DMIX, DM, (bf16_t*)(ws + WS_WOUT) + (size_t)l * DM * DMIX, scr, r, lane, 0, 1.f, true); }
    }
    float* rss0 = (float*)(ws + WS_RSS0); float* rss1 = (float*)(ws + WS_RSS1); bf16_t* xb = (bf16_t*)(ws + WS_XB);
    for (int row0 = gw * 4; row0 < T; row0 += ngw * 4) {
        float4 v[4][4];
#pragma unroll
        for (int q = 0; q < 4; ++q) { const float4* p = (const float4*)(P.x + (size_t)(row0 + q) * DM);
#pragma unroll
            for (int j = 0; j < 4; ++j) v[q][j] = p[lane + 64 * j]; }
#pragma unroll
        for (int q = 0; q < 4; ++q) {
            uint2* o = (uint2*)(xb + (size_t)(row0 + q) * DM);
            float s = 0.f;
#pragma unroll
            for (int j = 0; j < 4; ++j) { const float4 t = v[q][j]; s += t.x * t.x + t.y * t.y + t.z * t.z + t.w * t.w; uint2 w; w.x = pk2(t.x, t.y); w.y = pk2(t.z, t.w); o[lane + 64 * j] = w; }
#pragma unroll
            for (int of = 32; of > 0; of >>= 1) s += __shfl_xor(s, of);
            if (lane == 0) { rss0[row0 + q] = s; rss1[row0 + q] = 0.f; }
        }
    }
}

__device__ __forceinline__ void ph_final_norm(float* x, const float* w) {
    int tid_ = threadIdx.x; asm volatile("" : "+v"(tid_));
    const int lane = tid_ & 63, gw = blockIdx.x * (NT / 64) + (tid_ >> 6), ngw = gridDim.x * (NT / 64);
    for (int row = gw; row < T; row += ngw) {
        float4* p = (float4*)(x + (size_t)row * DM);
        float4 v[4]; float s = 0.f;
        for (int j = 0; j < 4; ++j) { v[j] = p[lane + 64 * j]; s += v[j].x * v[j].x + v[j].y * v[j].y + v[j].z * v[j].z + v[j].w * v[j].w; }
        for (int o = 32; o > 0; o >>= 1) s += __shfl_xor(s, o);
        const float r = rsqrtf(s * (1.f / DM) + EPS);
        for (int j = 0; j < 4; ++j) { float4 ww = ((const float4*)w)[lane + 64 * j]; float4 o4; o4.x = v[j].x * r * ww.x; o4.y = v[j].y * r * ww.y; o4.z = v[j].z * r * ww.z; o4.w = v[j].w * r * ww.w; p[lane + 64 * j] = o4; }
    }
}


namespace att {
#define ATT_LAS __attribute__((address_space(3)))
typedef short bf16x8 __attribute__((ext_vector_type(8)));
typedef short s16x4 __attribute__((ext_vector_type(4)));
typedef float f32x16 __attribute__((ext_vector_type(16)));
typedef ATT_LAS unsigned char* ldsp;
typedef unsigned u32x4 __attribute__((ext_vector_type(4)));
__device__ __forceinline__ int crow(int reg, int hh) { return (reg & 3) + 8 * (reg >> 2) + 4 * hh; }
__device__ __forceinline__ s16x4 vtr(ldsp p) { return __builtin_bit_cast(s16x4, __builtin_amdgcn_ds_read_tr16_b64_v4i16((ATT_LAS s16x4*)p)); }
typedef float f32x2_t __attribute__((ext_vector_type(2))); typedef __bf16 bf16x2_t __attribute__((ext_vector_type(2)));
__device__ __forceinline__ unsigned cvtpk(float lo, float hi) { f32x2_t v = {lo, hi}; bf16x2_t b = __builtin_convertvector(v, bf16x2_t); return __builtin_bit_cast(unsigned, b); }
#define ATT_MFMA(a, b, c) __builtin_amdgcn_mfma_f32_32x32x16_bf16((a), (b), (c), 0, 0, 0)

constexpr float ATT_THR = 6.0f;
__device__ __forceinline__ float max3f(float a, float b, float c) { float r; asm("v_max3_f32 %0, %1, %2, %3" : "=v"(r) : "v"(a), "v"(b), "v"(c)); return r; }
__device__ __forceinline__ float rowmax32(const f32x16& p0, const f32x16& p1) {
    float a = max3f(p0[0], p0[1], p1[0]), b = max3f(p0[2], p0[3], p1[1]); a = max3f(a, p1[2], p1[3]);
#pragma unroll
    for (int i = 4; i < 16; i += 4) { a = max3f(a, p0[i], p0[i + 1]); b = max3f(b, p0[i + 2], p0[i + 3]); a = max3f(a, p1[i], p1[i + 1]); b = max3f(b, p1[i + 2], p1[i + 3]); }
    float m = max3f(a, b, b);
    auto rr = __builtin_amdgcn_permlane32_swap(__float_as_uint(m), __float_as_uint(m), false, false);
    return max3f(__uint_as_float(rr[0]), __uint_as_float(rr[1]), m);
}

#define ATT_WAIT_BAR(N) asm volatile("s_waitcnt vmcnt(" #N ") lgkmcnt(0)\n\ts_barrier" ::: "memory")
#define ATT_ISSUE_K(pb, t) do { _Pragma("unroll") for (int i_ = 0; i_ < 2; ++i_) dma16((pb), ksrc[i_] + (unsigned)(t) * (128u * DIN), (unsigned)(size_t)(lds + KR + ((t) & 3) * 16384 + wid * 2048 + i_ * 1024)); } while (0)
#define ATT_ISSUE_V(pb, t) do { _Pragma("unroll") for (int i_ = 0; i_ < 2; ++i_) dma16((pb), vsrc[i_] + (unsigned)(t) * (128u * DIN), (unsigned)(size_t)(lds + VR + ((t) & 3) * 16384 + wid * 2048 + i_ * 1024)); } while (0)
#define ATT_LANE_SETUP() \
    int tid_ = threadIdx.x; asm volatile("" : "+v"(tid_)); \
    const int tid = tid_, lane = tid & 63, wid = __builtin_amdgcn_readfirstlane(tid >> 6), r = lane & 31, hh = lane >> 5; \
    const int mp = wid & 1, qs = wid >> 1, q0 = qblk * 128 + qs * 32; \
    unsigned ksrc[2], vsrc[2]; \
    _Pragma("unroll") for (int i = 0; i < 2; ++i) { \
        const int krow = 8 * wid + 4 * i + (lane >> 4), kc = (lane & 15) ^ (krow & 15); \
        ksrc[i] = 2u * (unsigned)(krow * DIN + C_AK + h * 128 + kc * 8); \
        const int vrow = 8 * wid + ((lane >> 2) & 7), vc = 4 * (2 * i + (lane >> 5)) + (lane & 3); \
        vsrc[i] = 2u * (unsigned)(vrow * DIN + C_AV + h * 128 + vc * 8); }
template <int TRAIL>
__device__ __forceinline__ void attn_run(ldsp lds, int i_lo, int i_hi, int xg  , int qblk, const bf16_t* __restrict__ proj, const float* __restrict__ tbl2, float lam, int layer, const float* __restrict__ subln_w, bf16_t* __restrict__ mixed) {
    if (i_lo >= i_hi) return;
    const int h = xg & 3;
    constexpr int NTILE = SEQ / 64;
    constexpr int KR = 0, VR = 65536, TBO = 131072, XB = 133120;
    __syncthreads();
    {
        ATT_LANE_SETUP();
        (void)r; (void)hh; (void)mp; (void)q0;
        const float tv = tbl2[h * 4096 + 2048 - 256 + tid]; ATT_LAS float* tbw = (ATT_LAS float*)(lds + TBO); tbw[tid] = tv;
        const bf16_t* pb0 = proj + (size_t)((i_lo * 16 + xg) >> 2) * SEQ * DIN;
        ATT_ISSUE_K(pb0, 0); ATT_ISSUE_V(pb0, 0); ATT_ISSUE_K(pb0, 1); ATT_ISSUE_V(pb0, 1);
    }
#define ATT_SIDE(t) (((t) * 64 + 63 - q0 <= -128) ? 0 : (((t) * 64 - (q0 + 31) >= 128) ? 2 : 1))
#define ATT_QK(P0, P1, t) do { const ldsp kp_ = lds + ((t) & 3) * 16384 + kbase; \
        f32x16 cin_; { const float c_ = (ATT_SIDE(t) == 2 ? bias_pos : bias_neg) - mref; _Pragma("unroll") for (int i_ = 0; i_ < 16; ++i_) cin_[i_] = c_; } \
        _Pragma("unroll") for (int s_ = 0; s_ < 4; ++s_) { const int co_ = ((mp * 8 + 2 * s_ + hh) ^ kx) * 16; \
            const bf16x8 ka_ = *(const ATT_LAS bf16x8*)(kp_ + co_), kb_ = *(const ATT_LAS bf16x8*)(kp_ + 8192 + co_); \
            if (s_ == 0) { P0 = ATT_MFMA(ka_, qf[0], cin_); P1 = ATT_MFMA(kb_, qf[0], cin_); } else { P0 = ATT_MFMA(ka_, qf[s_], P0); P1 = ATT_MFMA(kb_, qf[s_], P1); } } } while (0)
#define ATT_NEARFIX(P0, P1, t) do { if (ATT_SIDE(t) == 1) { const int rb_ = (t) * 64 - (q0 + r) + 256 + 4 * hh; \
            _Pragma("unroll") for (int i_ = 0; i_ < 16; ++i_) { const int k_ = rb_ + (i_ & 3) + 8 * (i_ >> 2); P0[i_] += tb[k_] - bias_neg; P1[i_] += tb[k_ + 32] - bias_neg; } } } while (0)
#define ATT_SB() __builtin_amdgcn_sched_barrier(0)
#define ATT_KRD(s_, half_) (*(const ATT_LAS bf16x8*)(kp_ + (half_) * 8192 + ((mp * 8 + 2 * (s_) + hh) ^ kx) * 16))
#define ATT_VRD(DST, j_) do { const s16x4 lo_ = vtr(vp_ + (2 * ((j_) >> 2)) * 2048 + ((j_) & 3) * 512), hi_ = vtr(vp_ + (2 * ((j_) >> 2) + 1) * 2048 + ((j_) & 3) * 512); \
        DST = (bf16x8){lo_[0], lo_[1], lo_[2], lo_[3], hi_[0], hi_[1], hi_[2], hi_[3]}; } while (0)
#define ATT_EXP8(P, i0) do { _Pragma("unroll") for (int i_ = (i0); i_ < (i0) + 8; ++i_) P[i_] = __builtin_amdgcn_exp2f(P[i_]); } while (0)
#define ATT_PACK(DST, P, i0) do { u32x4 wv_; _Pragma("unroll") for (int j_ = 0; j_ < 4; ++j_) wv_[j_] = cvtpk(P[(i0) + 2 * j_], P[(i0) + 2 * j_ + 1]); DST = __builtin_bit_cast(bf16x8, wv_); } while (0)
#define ATT_SUM8(P, i0) do { _Pragma("unroll") for (int i_ = (i0); i_ < (i0) + 8; ++i_) l += P[i_]; } while (0)
#define ATT_KPRE(tq) do { const ldsp kp_ = lds + ((tq) & 3) * 16384 + kbase; ka0_ = ATT_KRD(0, 0); kb0_ = ATT_KRD(0, 1); ka1_ = ATT_KRD(1, 0); kb1_ = ATT_KRD(1, 1); } while (0)
#define ATT_QKEXP(PC0, PC1, PN0, PN1, tq, tv, KPRE) do { \
        const ldsp kp_ = lds + ((tq) & 3) * 16384 + kbase; const ldsp vp_ = lds + ((tv) & 3) * 16384 + vbase; \
        { const float c_ = (ATT_SIDE(tq) == 2 ? bias_pos : bias_neg) - mref; if (__any(c_ != ccur_)) { ccur_ = c_; _Pragma("unroll") for (int i_ = 0; i_ < 16; ++i_) cin_[i_] = c_; } } \
        if (!(KPRE)) { ka0_ = ATT_KRD(0, 0); kb0_ = ATT_KRD(0, 1); ka1_ = ATT_KRD(1, 0); kb1_ = ATT_KRD(1, 1); } \
        ATT_SB(); \
        ATT_EXP8(PC0, 0); \
        ATT_SB(); \
        PN0 = ATT_MFMA(ka0_, qf[0], cin_); PN1 = ATT_MFMA(kb0_, qf[0], cin_); ka0_ = ATT_KRD(2, 0); kb0_ = ATT_KRD(2, 1); ATT_EXP8(PC0, 8); \
        ATT_SB(); \
        PN0 = ATT_MFMA(ka1_, qf[1], PN0); PN1 = ATT_MFMA(kb1_, qf[1], PN1); ka1_ = ATT_KRD(3, 0); kb1_ = ATT_KRD(3, 1); ATT_EXP8(PC1, 0); \
        ATT_SB(); \
        PN0 = ATT_MFMA(ka0_, qf[2], PN0); PN1 = ATT_MFMA(kb0_, qf[2], PN1); ATT_VRD(vf0_, 0); ATT_VRD(vf1_, 1); ATT_EXP8(PC1, 8); \
        ATT_SB(); \
        PN0 = ATT_MFMA(ka1_, qf[3], PN0); PN1 = ATT_MFMA(kb1_, qf[3], PN1); ATT_VRD(vf2_, 2); ATT_VRD(vf3_, 3); ATT_PACK(pk0_, PC0, 0); ATT_SUM8(PC0, 0); \
        ATT_SB(); } while (0)
#define ATT_PV4(g_, PKCUR, NEXTWORK) do { \
        o[0] = ATT_MFMA(vf0_, PKCUR, o[0]); if ((g_) < 3) ATT_VRD(vf0_, 4 * (g_) + 4); NEXTWORK; ATT_SB(); \
        o[1] = ATT_MFMA(vf1_, PKCUR, o[1]); if ((g_) < 3) ATT_VRD(vf1_, 4 * (g_) + 5); ATT_SB(); \
        o[2] = ATT_MFMA(vf2_, PKCUR, o[2]); if ((g_) < 3) ATT_VRD(vf2_, 4 * (g_) + 6); ATT_SB(); \
        o[3] = ATT_MFMA(vf3_, PKCUR, o[3]); if ((g_) < 3) ATT_VRD(vf3_, 4 * (g_) + 7); ATT_SB(); } while (0)
#define ATT_PVBLOCK(PC0, PC1, tv, RMWORK, TAILWORK) do { const ldsp vp_ = lds + ((tv) & 3) * 16384 + vbase; bf16x8 pk1_; __builtin_amdgcn_s_setprio(1); \
        ATT_PV4(0, pk0_, do { ATT_PACK(pk1_, PC0, 8); ATT_SUM8(PC0, 8); } while (0)); \
        ATT_PV4(1, pk1_, do { ATT_PACK(pk0_, PC1, 0); ATT_SUM8(PC1, 0); } while (0)); \
        ATT_PV4(2, pk0_, do { ATT_PACK(pk1_, PC1, 8); ATT_SUM8(PC1, 8); RMWORK; } while (0)); \
        ATT_PV4(3, pk1_, TAILWORK); __builtin_amdgcn_s_setprio(0); } while (0)
#define ATT_RESCALE(P0, P1) do { \
        if (__any(mt_ > ATT_THR)) { const float dl_ = mt_ > ATT_THR ? mt_ : 0.f; const float f_ = __builtin_amdgcn_exp2f(-dl_); mref += dl_; l *= f_; \
            _Pragma("unroll") for (int d_ = 0; d_ < 4; ++d_) _Pragma("unroll") for (int i_ = 0; i_ < 16; ++i_) o[d_][i_] *= f_; \
            _Pragma("unroll") for (int i_ = 0; i_ < 16; ++i_) { P0[i_] -= dl_; P1[i_] -= dl_; } } } while (0)
#define ATT_DMA(t) do { if ((t) + 2 < NTILE) ATT_ISSUE_V(pbat, (t) + 2); if ((t) + 4 < NTILE) ATT_ISSUE_K(pbat, (t) + 4); } while (0)
#define ATT_CLOSE(t) do { if ((t) + 4 < NTILE) ATT_WAIT_BAR(6); else if ((t) + 4 == NTILE) ATT_WAIT_BAR(4); else if ((t) + 3 == NTILE) ATT_WAIT_BAR(2); else ATT_WAIT_BAR(0); } while (0)
#define ATT_STEP_L(PC0, PC1, PN0, PN1, t) do { float mt_ = 0.f; \
        ATT_DMA(t); \
        ATT_QKEXP(PC0, PC1, PN0, PN1, (t) + 1, t, false); \
        if ((t) + 1 < NTILE) ATT_NEARFIX(PN0, PN1, (t) + 1); \
        ATT_PVBLOCK(PC0, PC1, t, mt_ = rowmax32(PN0, PN1), (void)0); \
        if ((t) + 1 < NTILE) ATT_RESCALE(PN0, PN1); \
        ATT_CLOSE(t); } while (0)
#define ATT_STEP_T(PP0, PP1, PC0, PC1, t) do { float mt_ = 0.f; \
        if ((t) > 0) { ATT_NEARFIX(PC0, PC1, t); ATT_PVBLOCK(PP0, PP1, (t) - 1, mt_ = rowmax32(PC0, PC1), ATT_KPRE((t) + 1)); ATT_RESCALE(PC0, PC1); } else ATT_KPRE((t) + 1); \
        ATT_DMA(t);                                                \
        ATT_QKEXP(PC0, PC1, PP0, PP1, (t) + 1, t, true);          \
        ATT_CLOSE(t); } while (0)
    bf16x8 qf[4];
    {
        ATT_LANE_SETUP();
        (void)ksrc; (void)vsrc;
        const bf16_t* qp = proj + ((size_t)((i_lo * 16 + xg) >> 2) * SEQ + q0 + r) * DIN + C_AQ + h * 128 + mp * 64 + hh * 8;
#pragma unroll
        for (int s = 0; s < 4; ++s) qf[s] = *(const bf16x8*)(qp + 16 * s);
    }
    for (int it = i_lo; it < i_hi; ++it) {
        ATT_LANE_SETUP();
        const int b = (it * 16 + xg) >> 2;
        const size_t tok0 = (size_t)b * SEQ;
        const bf16_t* pbat = proj + tok0 * DIN;
        const ATT_LAS float* tb = (const ATT_LAS float*)(lds + TBO);
        const int kbase = KR + r * 256, kx = r & 15;
        const int vbase = VR + (4 * hh + ((lane & 15) >> 2)) * 64 + ((lane >> 4) & 1) * 32 + (lane & 3) * 8;
        asm volatile("s_waitcnt lgkmcnt(0)\n\ts_barrier" ::: "memory");
        ATT_ISSUE_K(pbat, 2); ATT_ISSUE_K(pbat, 3);
        ATT_WAIT_BAR(10);
        const float bias_neg = tb[0], bias_pos = tb[511];
        f32x16 o[4];
#pragma unroll
        for (int d = 0; d < 4; ++d)
#pragma unroll
            for (int i = 0; i < 16; ++i) o[d][i] = 0.f;
        float mref = 0.f, l = 0.f;
        f32x16 pA0, pA1, pB0, pB1;
        ATT_QK(pA0, pA1, 0); ATT_NEARFIX(pA0, pA1, 0);
        { const float m0 = rowmax32(pA0, pA1); mref = m0;
#pragma unroll
          for (int i = 0; i < 16; ++i) { pA0[i] -= m0; pA1[i] -= m0; } }
        asm volatile("s_waitcnt lgkmcnt(0)\n\ts_barrier" ::: "memory");
        bf16x8 vf0_, vf1_, vf2_, vf3_, pk0_, ka0_, kb0_, ka1_, kb1_;
        f32x16 cin_; float ccur_ = __builtin_nanf("");
        if constexpr (TRAIL == 0) {
            for (int t = 0; t < NTILE; t += 2) {
                ATT_STEP_L(pA0, pA1, pB0, pB1, t);
                ATT_STEP_L(pB0, pB1, pA0, pA1, t + 1);
            }
        } else {
            for (int t = 0; t < NTILE; t += 2) {
                ATT_STEP_T(pB0, pB1, pA0, pA1, t);
                ATT_STEP_T(pA0, pA1, pB0, pB1, t + 1);
            }
            { float mt_ = 0.f; (void)mt_; ATT_PVBLOCK(pB0, pB1, NTILE - 1, (void)0, (void)0); }
        }
        __builtin_amdgcn_s_setprio(0);
        if (it + 1 < i_hi) { const bf16_t* pbn = proj + (size_t)(((it + 1) * 16 + xg) >> 2) * SEQ * DIN; ATT_ISSUE_K(pbn, 0); ATT_ISSUE_V(pbn, 0); ATT_ISSUE_K(pbn, 1); ATT_ISSUE_V(pbn, 1); }
#define ATT_NEXT_Q() do { if (it + 1 < i_hi) { const bf16_t* qp_ = proj + ((size_t)(((it + 1) * 16 + xg) >> 2) * SEQ + q0 + r) * DIN + C_AQ + h * 128 + mp * 64 + hh * 8; \
            _Pragma("unroll") for (int s_ = 0; s_ < 4; ++s_) qf[s_] = *(const bf16x8*)(qp_ + 16 * s_); } } while (0)
        const size_t trow = tok0 + q0 + r;
        const float ltot = l + __shfl_xor(l, 32);
        const float inv = __builtin_amdgcn_rcpf(ltot);
        ATT_LAS float* xw = (ATT_LAS float*)(lds + (qs == 0 ? KR + 3 * 16384 : qs == 1 ? KR + 2 * 16384 : qs == 2 ? VR + 2 * 16384 : XB)) + lane;
        if (mp == 1) {
            const float sc1 = lam * inv;
#pragma unroll
            for (int d = 0; d < 4; ++d)
#pragma unroll
                for (int i = 0; i < 16; ++i) xw[(d * 16 + i) * 64] = o[d][i] * sc1;
            ATT_NEXT_Q();
            asm volatile("s_waitcnt lgkmcnt(0)\n\ts_barrier" ::: "memory");
        } else {
            u32x4 gr[8];
            { const bf16_t* gsrc0 = proj + (tok0 + q0) * DIN + C_AG + h * 128;
#pragma unroll
              for (int i = 0; i < 8; ++i) { const int e = lane + 64 * i; gr[i] = *(const u32x4*)(gsrc0 + (size_t)(e >> 4) * DIN + (e & 15) * 8); } }
            asm volatile("s_waitcnt lgkmcnt(0)\n\ts_barrier" ::: "memory");
            float ss = 0.f;
#pragma unroll
            for (int d = 0; d < 4; ++d) {
#pragma unroll
                for (int i = 0; i < 16; ++i) { const float v = o[d][i] * inv - xw[(d * 16 + i) * 64]; o[d][i] = v; ss += v * v; }
                asm volatile("" ::: "memory");
            }
            ss += __shfl_xor(ss, 32);
            int ly_ = layer; asm volatile("" : "+s"(ly_));
            const float rs = rsqrtf(ss * (1.f / 128.f) + EPS) * (ly_ == 0 ? 0.8f : 0.64449093f);
            typedef unsigned u32x2 __attribute__((ext_vector_type(2)));
            const ldsp tl = (ldsp)xw - lane * 4;
            bf16_t* odst = mixed + (tok0 + q0) * DMIX + h * 128;
#pragma unroll
            for (int i = 0; i < 8; ++i) { const int e = lane + 64 * i; const ldsp gd = tl + (e >> 4) * 264 + (e & 15) * 16; *(ATT_LAS u32x2*)gd = (u32x2){gr[i][0], gr[i][1]}; *(ATT_LAS u32x2*)(gd + 8) = (u32x2){gr[i][2], gr[i][3]}; }
            ATT_NEXT_Q();
            asm volatile("s_waitcnt lgkmcnt(0)" ::: "memory");
            const ldsp tr_ = tl + r * 264 + 8 * hh;
#pragma unroll
            for (int d = 0; d < 4; ++d)
#pragma unroll
                for (int g = 0; g < 4; ++g) {
                    const int dd = d * 32 + 8 * g;
                    const u32x2 gv = *(const ATT_LAS u32x2*)(tr_ + dd * 2);
                    const float4 sw = *(const float4*)(subln_w + dd + 4 * hh);
                    const float g0 = __uint_as_float(gv.x << 16), g1 = __uint_as_float(gv.x & 0xffff0000u), g2 = __uint_as_float(gv.y << 16), g3 = __uint_as_float(gv.y & 0xffff0000u);
                    u32x2 w; w.x = pk2(o[d][4 * g] * rs * sw.x * g0, o[d][4 * g + 1] * rs * sw.y * g1); w.y = pk2(o[d][4 * g + 2] * rs * sw.z * g2, o[d][4 * g + 3] * rs * sw.w * g3);
                    *(ATT_LAS u32x2*)(tr_ + dd * 2) = w;
                }
            asm volatile("s_waitcnt lgkmcnt(0)" ::: "memory");
#pragma unroll
            for (int i = 0; i < 8; ++i) { const int e = lane + 64 * i; const ldsp od = tl + (e >> 4) * 264 + (e & 15) * 16; const u32x2 a0 = *(const ATT_LAS u32x2*)od, a1 = *(const ATT_LAS u32x2*)(od + 8);
                *(u32x4*)(odst + (size_t)(e >> 4) * DMIX + (e & 15) * 8) = (u32x4){a0.x, a0.y, a1.x, a1.y}; }
        }
    }
    asm volatile("s_waitcnt vmcnt(0)" ::: "memory");
#undef ATT_ISSUE_K
#undef ATT_WAIT_BAR
#undef ATT_ISSUE_V
#undef ATT_LANE_SETUP
#undef ATT_SIDE
#undef ATT_QK
#undef ATT_NEARFIX
#undef ATT_STEP_L
#undef ATT_STEP_T
#undef ATT_QKEXP
#undef ATT_KPRE
#undef ATT_PVBLOCK
#undef ATT_RESCALE
#undef ATT_DMA
#undef ATT_CLOSE
#undef ATT_NEXT_Q
#undef ATT_SB
#undef ATT_KRD
#undef ATT_VRD
#undef ATT_EXP8
#undef ATT_PACK
#undef ATT_SUM8
#undef ATT_PV4
}
__device__ __forceinline__ void attn_phase(ldsp lds, int i_lo, int i_hi, const bf16_t* proj, const float* tbl2, const float* diff_lambda, int layer, const float* subln_w, bf16_t* mixed) {
    asm volatile("" : "+s"(layer));
    const float lamv = diff_lambda[0];
    const float lam = __builtin_bit_cast(float, __builtin_amdgcn_readfirstlane(__builtin_bit_cast(int, lamv)));
    const int bid = blockIdx.x, xcd = bid & 7, slot = bid >> 3;
    if (__builtin_amdgcn_readfirstlane((int)threadIdx.x >> 6) >= 4) attn_run<1>(lds, i_lo, i_hi, xcd * 2 + (slot >> 4), slot & 15, proj, tbl2, lam, layer, subln_w, mixed);
    else attn_run<0>(lds, i_lo, i_hi, xcd * 2 + (slot >> 4), slot & 15, proj, tbl2, lam, layer, subln_w, mixed);
}
}

namespace ret {
using att::ldsp; using att::bf16x8; using att::s16x4; using att::f32x16; using att::u32x4; using att::vtr; using att::cvtpk; using att::crow;
constexpr size_t WS_RST = 480 * MiB;

__device__ __forceinline__ void ret_state_item(ldsp lds, int item, const bf16_t* __restrict__ proj, const float* __restrict__ decay_logit, bf16_t* __restrict__ rst, unsigned* cnt) {
    int tid_ = threadIdx.x; asm volatile("" : "+v"(tid_));
    const int tid = tid_, lane = tid & 63, wid = __builtin_amdgcn_readfirstlane(tid >> 6), r = lane & 31, hh = lane >> 5;
    const int vhalf = item & 1, dir = (item >> 1) & 1, h = (item >> 2) & 3, b = item >> 4;
    const int dblk = wid & 1, vblk = (wid >> 1) & 1;
    const float lg2 = decay_logit[dir * 4 + h];
    const float cd = __builtin_amdgcn_exp2f(lg2 * 128.f);
    const size_t tok0 = (size_t)b * SEQ;
    constexpr int KT = 0, VT = 16384, STG = 32768;
    const int m0 = tid >> 3, c8 = tid & 7;
    const unsigned gk = (unsigned)((tok0 + m0) * DIN + C_BK + h * 64 + c8 * 8), gv = (unsigned)((tok0 + m0) * DIN + C_BV + h * 128 + vhalf * 64 + c8 * 8);
    const int ldst = ((m0 >> 3) * 2 + (c8 >> 2)) * 512 + (m0 & 7) * 64 + (c8 & 3) * 16;
    const float sc0 = 0.125f * __builtin_amdgcn_exp2f(lg2 * (float)(dir == 0 ? 127 - m0 : m0)), sc1 = 0.125f * __builtin_amdgcn_exp2f(lg2 * (float)(dir == 0 ? 63 - m0 : m0 + 64));
    u32x4 kA[2], vA[2], kB[2], vB[2];
#define RS_ISSUE(KR, VR, c) do { _Pragma("unroll") for (int i_ = 0; i_ < 2; ++i_) { const unsigned o_ = (unsigned)((c) * 128 + 64 * i_) * DIN; KR[i_] = *(const u32x4*)(proj + gk + o_); VR[i_] = *(const u32x4*)(proj + gv + o_); } } while (0)
#define RS_COMMIT(KR, VR, buf) do { _Pragma("unroll") for (int i_ = 0; i_ < 2; ++i_) { const float sc_ = i_ == 0 ? sc0 : sc1; u32x4 w_; \
            _Pragma("unroll") for (int j_ = 0; j_ < 4; ++j_) { const unsigned u_ = KR[i_][j_]; w_[j_] = cvtpk(__uint_as_float(u_ << 16) * sc_, __uint_as_float(u_ & 0xffff0000u) * sc_); } \
            *(ATT_LAS u32x4*)(lds + (buf) * STG + KT + ldst + i_ * 8192) = w_; *(ATT_LAS u32x4*)(lds + (buf) * STG + VT + ldst + i_ * 8192) = VR[i_]; } } while (0)
#define RS_CHUNK(i) (dir == 0 ? (i) : 15 - (i))
    f32x16 acc;
#pragma unroll
    for (int i = 0; i < 16; ++i) acc[i] = 0.f;
    const int trb = ((lane & 15) >> 2) * 64 + ((lane >> 4) & 1) * 32 + (lane & 3) * 8 + hh * 1024;
#define RS_STEP(i, KR, VR) do { const int c_ = RS_CHUNK(i), buf_ = (i) & 1; \
        if (wid < 4) { bf16_t* dst_ = rst + ((((size_t)(b * 4 + h) * 16 + c_) * 2 + dir) * 128 + vhalf * 64 + vblk * 32 + r) * 64 + dblk * 32 + 4 * hh; \
            _Pragma("unroll") for (int g_ = 0; g_ < 4; ++g_) { uint2 w_; w_.x = cvtpk(acc[4 * g_], acc[4 * g_ + 1]); w_.y = cvtpk(acc[4 * g_ + 2], acc[4 * g_ + 3]); *(uint2*)(dst_ + 8 * g_) = w_; } \
            _Pragma("unroll") for (int k_ = 0; k_ < 16; ++k_) acc[k_] *= cd; \
            const ldsp kp_ = lds + buf_ * STG + KT + dblk * 512 + trb, vp_ = lds + buf_ * STG + VT + vblk * 512 + trb; \
            _Pragma("unroll") for (int ks_ = 0; ks_ < 8; ++ks_) { \
                const s16x4 alo_ = vtr(kp_ + ks_ * 2048), ahi_ = vtr(kp_ + ks_ * 2048 + 256), blo_ = vtr(vp_ + ks_ * 2048), bhi_ = vtr(vp_ + ks_ * 2048 + 256); \
                const bf16x8 a_ = {alo_[0], alo_[1], alo_[2], alo_[3], ahi_[0], ahi_[1], ahi_[2], ahi_[3]}, bb_ = {blo_[0], blo_[1], blo_[2], blo_[3], bhi_[0], bhi_[1], bhi_[2], bhi_[3]}; \
                acc = ATT_MFMA(a_, bb_, acc); } } \
        if ((i) + 1 < 16) RS_COMMIT(KR, VR, buf_ ^ 1); \
        if ((i) + 3 < 16) RS_ISSUE(KR, VR, RS_CHUNK((i) + 3)); \
        __syncthreads(); } while (0)
    __syncthreads();
    RS_ISSUE(kA, vA, RS_CHUNK(0)); RS_ISSUE(kB, vB, RS_CHUNK(1));
    RS_COMMIT(kA, vA, 0);
    RS_ISSUE(kA, vA, RS_CHUNK(2));
    __syncthreads();
    for (int i = 0; i < 16; i += 2) {
        RS_STEP(i, kB, vB);
        RS_STEP(i + 1, kA, vA);
    }
#undef RS_ISSUE
#undef RS_COMMIT
#undef RS_CHUNK
#undef RS_STEP
    asm volatile("s_waitcnt vmcnt(0)" ::: "memory");
    __syncthreads();
    if (tid == 0) { __builtin_amdgcn_fence(__ATOMIC_RELEASE, "agent"); asm volatile("s_waitcnt vmcnt(0)" ::: "memory"); __hip_atomic_fetch_add(cnt + (item >> 2), 1u, __ATOMIC_RELAXED, __HIP_MEMORY_SCOPE_AGENT); }
}
__device__ __forceinline__ void ret_wait_states(const unsigned* cnt, int bh0, int bh_stride, int n) {
    if (threadIdx.x == 0) {
        for (int i = 0; i < n; ++i) { unsigned sp = 0; while (__hip_atomic_load(cnt + bh0 + i * bh_stride, __ATOMIC_RELAXED, __HIP_MEMORY_SCOPE_AGENT) < 4u && ++sp < (1u << 20)) __builtin_amdgcn_s_sleep(2); }
        __builtin_amdgcn_fence(__ATOMIC_ACQUIRE, "agent"); asm volatile("s_waitcnt vmcnt(0)" ::: "memory");
    }
    __syncthreads();
}

__device__ __forceinline__ void ret_out_run(ldsp lds, int first, int stride, int nitems, const bf16_t* __restrict__ proj, const float* __restrict__ decay_logit, const bf16_t* __restrict__ rst, bf16_t* __restrict__ mixed) {
    int tid_ = threadIdx.x; asm volatile("" : "+v"(tid_));
    const int tid = tid_, lane = tid & 63, wid = __builtin_amdgcn_readfirstlane(tid >> 6), r = lane & 31, hh = lane >> 5;
    const int vhalf = wid & 1, nblk = wid >> 1;
    constexpr int KT = 0, VT = 16384, SLOT = 49152, RT = 2 * SLOT, SS = RT + 32768;
    unsigned ksrc[2], vsrc[4], rsrc[4];
#pragma unroll
    for (int i = 0; i < 2; ++i) { const int row = 16 * wid + 8 * i + (lane >> 3), ch = (lane & 7) ^ ((row >> 1) & 7); ksrc[i] = (unsigned)(row * DIN + C_BK + ch * 8); }
#pragma unroll
    for (int i = 0; i < 4; ++i) { const int row = 16 * wid + 8 * (i >> 1) + ((lane >> 2) & 7), ch = 4 * (2 * (i & 1) + (lane >> 5)) + (lane & 3); vsrc[i] = (unsigned)(row * DIN + C_BV + ch * 8); }
#pragma unroll
    for (int i = 0; i < 4; ++i) { const int pc = 4 * wid + i, row = 8 * (pc & 15) + (lane >> 3), ch = (lane & 7) ^ ((row >> 1) & 7); rsrc[i] = (unsigned)((pc >> 4) * 8192 + row * 64 + ch * 8); }
#define RO_DMA_KV(it, slot) do { const int c_ = (it) & 15, h_ = ((it) >> 4) & 3, b_ = (it) >> 6; const bf16_t* base_ = proj + ((size_t)b_ * SEQ + (size_t)c_ * 128) * DIN; \
        _Pragma("unroll") for (int i_ = 0; i_ < 2; ++i_) dma16(base_, 2u * (ksrc[i_] + (unsigned)h_ * 64u), (unsigned)(size_t)(lds + (slot) * SLOT + KT + wid * 2048 + i_ * 1024)); \
        _Pragma("unroll") for (int i_ = 0; i_ < 4; ++i_) dma16(base_, 2u * (vsrc[i_] + (unsigned)h_ * 128u), (unsigned)(size_t)(lds + (slot) * SLOT + VT + wid * 4096 + i_ * 1024)); } while (0)
#define RO_DMA_R(it) do { const bf16_t* base_ = rst + (size_t)((((it) >> 6) * 4 + (((it) >> 4) & 3)) * 16 + ((it) & 15)) * 2 * 8192; \
        _Pragma("unroll") for (int i_ = 0; i_ < 4; ++i_) dma16(base_, 2u * rsrc[i_], (unsigned)(size_t)(lds + RT + wid * 4096 + i_ * 1024)); } while (0)
#define RO_LOADQ(QF, it) do { const bf16_t* qp_ = proj + ((size_t)((it) >> 6) * SEQ + (size_t)((it) & 15) * 128 + nblk * 32 + r) * DIN + C_BQ + (((it) >> 4) & 3) * 64 + hh * 8; \
        _Pragma("unroll") for (int s_ = 0; s_ < 4; ++s_) QF[s_] = *(const bf16x8*)(qp_ + 16 * s_); } while (0)
    bf16x8 qn[4];
    __syncthreads();
    if (first < nitems) { RO_LOADQ(qn, first); RO_DMA_KV(first, 0); }
    asm volatile("s_waitcnt vmcnt(0)" ::: "memory");
    int slot = 0;
    for (int item = first; item < nitems; item += stride, slot ^= 1) {
        const int c = item & 15, h = (item >> 4) & 3, b = item >> 6;
        const float lgf = decay_logit[h], lgb = decay_logit[4 + h];
        const size_t tok0 = (size_t)b * SEQ + (size_t)c * 128;
        const int n = nblk * 32 + r;
        bf16x8 qf[4];
#pragma unroll
        for (int s = 0; s < 4; ++s) qf[s] = qn[s];
        asm volatile("s_waitcnt vmcnt(8) lgkmcnt(0)\n\ts_barrier" ::: "memory");
        RO_DMA_R(item);
        uint2 gvr[8];
        { const bf16_t* gp_ = proj + (tok0 + n) * DIN + C_BG + h * 128 + vhalf * 64 + 4 * hh;
#pragma unroll
          for (int j = 0; j < 8; ++j) gvr[j] = *(const uint2*)(gp_ + (j >> 2) * 32 + 8 * (j & 3)); }
        const bool has_next = item + stride < nitems;
        const ldsp kt = lds + slot * SLOT + KT, vt = lds + slot * SLOT + VT;
        f32x16 oi[2], of[2], ob[2];
#pragma unroll
        for (int v = 0; v < 2; ++v)
#pragma unroll
            for (int i = 0; i < 16; ++i) { oi[v][i] = 0.f; of[v][i] = 0.f; ob[v][i] = 0.f; }
        const int vbase = (4 * hh + ((lane & 15) >> 2)) * 64 + ((lane >> 4) & 1) * 32 + (lane & 3) * 8;
#pragma unroll
        for (int mb = 0; mb < 4; ++mb) {
            f32x16 p;
#pragma unroll
            for (int i = 0; i < 16; ++i) p[i] = 0.f;
            { const int m = mb * 32 + r; const int kb = m * 128, kx = (m >> 1) & 7;
#pragma unroll
              for (int s = 0; s < 4; ++s) { const bf16x8 ka = *(const ATT_LAS bf16x8*)(kt + kb + (((2 * s + hh) ^ kx) * 16)); p = ATT_MFMA(ka, qf[s], p); } }
#pragma unroll
            for (int i = 0; i < 16; ++i) {
                const int m = mb * 32 + crow(i, hh); const float dl = (float)(n - m);
                p[i] *= __builtin_amdgcn_exp2f(dl * (n >= m ? lgf : -lgb) - 3.f);
            }
#pragma unroll
            for (int s = 0; s < 2; ++s) {
                u32x4 wv;
#pragma unroll
                for (int j = 0; j < 4; ++j) wv[j] = cvtpk(p[8 * s + 2 * j], p[8 * s + 2 * j + 1]);
                const bf16x8 pb = __builtin_bit_cast(bf16x8, wv);
#pragma unroll
                for (int vb = 0; vb < 2; ++vb) {
                    const ldsp vp = vt + vbase + (vhalf * 2 + vb) * 512 + (4 * mb + 2 * s) * 2048;
                    const s16x4 lo = vtr(vp), hi = vtr(vp + 2048);
                    const bf16x8 va = {lo[0], lo[1], lo[2], lo[3], hi[0], hi[1], hi[2], hi[3]};
                    oi[vb] = ATT_MFMA(va, pb, oi[vb]);
                }
            }
        }
        asm volatile("s_waitcnt vmcnt(0) lgkmcnt(0)\n\ts_barrier" ::: "memory");
        if (has_next) RO_DMA_KV(item + stride, slot ^ 1);
#pragma unroll
        for (int vb = 0; vb < 2; ++vb) {
            const int v = vhalf * 64 + vb * 32 + r; const int rbase = RT + v * 128, rx = (v >> 1) & 7;
#pragma unroll
            for (int s = 0; s < 4; ++s) {
                const int co = ((2 * s + hh) ^ rx) * 16;
                const bf16x8 af = *(const ATT_LAS bf16x8*)(lds + rbase + co), ab = *(const ATT_LAS bf16x8*)(lds + rbase + 16384 + co);
                of[vb] = ATT_MFMA(af, qf[s], of[vb]); ob[vb] = ATT_MFMA(ab, qf[s], ob[vb]);
            }
        }
        const float qdf = __builtin_amdgcn_exp2f(lgf * (float)(n + 1)), qdb = __builtin_amdgcn_exp2f(lgb * (float)(128 - n));
        float ss = 0.f;
#pragma unroll
        for (int vb = 0; vb < 2; ++vb)
#pragma unroll
            for (int i = 0; i < 16; ++i) { const float v = oi[vb][i] + qdf * of[vb][i] + qdb * ob[vb][i]; oi[vb][i] = v; ss += v * v; }
        ss += __shfl_xor(ss, 32);
        ATT_LAS float* sx = (ATT_LAS float*)(lds + SS + (slot & 1) * 1024);
        if (hh == 0) sx[wid * 32 + r] = ss;
        asm volatile("s_waitcnt lgkmcnt(0)\n\ts_barrier" ::: "memory");
        const float tot = sx[wid * 32 + r] + sx[(wid ^ 1) * 32 + r];
        const float rs = rsqrtf(tot * (1.f / 128.f) + EPS);
        const size_t trow = tok0 + n;
        bf16_t* op = mixed + trow * DMIX + 512 + h * 128 + vhalf * 64 + 4 * hh;
        if (has_next) RO_LOADQ(qn, item + stride);
#pragma unroll
        for (int vb = 0; vb < 2; ++vb)
#pragma unroll
            for (int g = 0; g < 4; ++g) {
                const int dd = vb * 32 + 8 * g;
                const uint2 gv = gvr[vb * 4 + g];
                const float g0 = __uint_as_float(gv.x << 16), g1 = __uint_as_float(gv.x & 0xffff0000u), g2 = __uint_as_float(gv.y << 16), g3 = __uint_as_float(gv.y & 0xffff0000u);
                uint2 w; w.x = pk2(oi[vb][4 * g] * rs * g0, oi[vb][4 * g + 1] * rs * g1); w.y = pk2(oi[vb][4 * g + 2] * rs * g2, oi[vb][4 * g + 3] * rs * g3);
                *(uint2*)(op + dd) = w;
            }
    }
#undef RO_DMA_KV
#undef RO_DMA_R
#undef RO_LOADQ
}
}

namespace pool {
using att::ldsp; using att::bf16x8; using att::f32x16; using att::u32x4; using att::cvtpk; using att::crow;
typedef unsigned u32x2 __attribute__((ext_vector_type(2)));
constexpr size_t WS_PW = 28 * MiB;
__device__ __forceinline__ void pool_item(ldsp lds, int item, const bf16_t* __restrict__ proj, const bf16_t* __restrict__ pwT, const float* __restrict__ pool_scale, bf16_t* __restrict__ mixed) {
    int tid_ = threadIdx.x; asm volatile("" : "+v"(tid_));
    const int tid = tid_, lane = tid & 63, wid = __builtin_amdgcn_readfirstlane(tid >> 6), r = lane & 31, hh = lane >> 5;
    const int tokblk = wid >> 1, dhalf = wid & 1;
    const int t0 = item * 128, pos0 = t0 & (SEQ - 1);
    constexpr int RAW = 0, PL = 36864, GT = 69632, OT = 103424, RS = 264;
    u32x4 rreg[5];
#define PL_ISSUE(g) do { _Pragma("unroll") for (int i_ = 0; i_ < 5; ++i_) { const int e_ = tid + 512 * i_, row_ = e_ >> 4, pos_ = pos0 - 8 + row_; rreg[i_] = (u32x4){0u, 0u, 0u, 0u}; \
            if (e_ < 2304 && pos_ >= 0 && pos_ < SEQ) rreg[i_] = *(const u32x4*)(proj + (size_t)(t0 - 8 + row_) * DIN + C_CU + (g) * 128 + (e_ & 15) * 8); } } while (0)
#define PL_COMMIT() do { _Pragma("unroll") for (int i_ = 0; i_ < 5; ++i_) { const int e_ = tid + 512 * i_; if (e_ < 2304) *(ATT_LAS u32x4*)(lds + RAW + e_ * 16) = rreg[i_]; } } while (0)
    const int tok = tokblk * 32 + r;
    const size_t trow = (size_t)t0 + tok;
    __syncthreads();
    PL_ISSUE(0);
    PL_COMMIT();
    for (int g = 0; g < 4; ++g) {
        const int w2 = 1 << g;
        __syncthreads();
        bf16x8 af[2][8];
        { const bf16_t* wg = pwT + (size_t)g * 128 * 128 + (size_t)(dhalf * 64 + r) * 128 + hh * 8;
#pragma unroll
          for (int db = 0; db < 2; ++db)
#pragma unroll
              for (int ks = 0; ks < 8; ++ks) af[db][ks] = *(const bf16x8*)(wg + db * 32 * 128 + ks * 16); }
        const float* psc = pool_scale + g * 128 + dhalf * 64 + 4 * hh;
        float4 scv[2][4];
#pragma unroll
        for (int db = 0; db < 2; ++db)
#pragma unroll
            for (int q = 0; q < 4; ++q) scv[db][q] = *(const float4*)(psc + db * 32 + 8 * q);
        u32x4 greg[4];
#pragma unroll
        for (int i = 0; i < 4; ++i) { const int e = tid + 512 * i; greg[i] = *(const u32x4*)(proj + (size_t)(t0 + (e >> 4)) * DIN + C_CG + g * 128 + (e & 15) * 8); }
        if (g + 1 < 4) PL_ISSUE(g + 1);
        {
            const int cc = tid & 15, tb = (tid >> 4) * 4;
            const ATT_LAS u32x4* raw = (const ATT_LAS u32x4*)(lds + RAW) + cc;
            float s[8];
#pragma unroll
            for (int j = 0; j < 8; ++j) s[j] = 0.f;
#define PL_ACC(SGN, row) do { const u32x4 v_ = raw[(row) * 16]; _Pragma("unroll") for (int j_ = 0; j_ < 4; ++j_) { s[2 * j_] += SGN __uint_as_float(v_[j_] << 16); s[2 * j_ + 1] += SGN __uint_as_float(v_[j_] & 0xffff0000u); } } while (0)
            for (int p = tb - w2; p < tb + w2; ++p) PL_ACC(+, p + 8);
#pragma unroll
            for (int tt = 0; tt < 4; ++tt) {
                const int t = tb + tt, pos = pos0 + t;
                int lo = pos - w2; if (lo < 0) lo = 0; int hi = pos + w2; if (hi > SEQ) hi = SEQ;
                const float inv = 1.f / (float)(hi - lo);
                const u32x4 cur = raw[(t + 8) * 16]; u32x4 w;
#pragma unroll
                for (int j = 0; j < 4; ++j) w[j] = cvtpk(s[2 * j] * inv - __uint_as_float(cur[j] << 16), s[2 * j + 1] * inv - __uint_as_float(cur[j] & 0xffff0000u));
                *(ATT_LAS u32x4*)(lds + PL + t * 256 + ((cc ^ (t & 15)) * 16)) = w;
                if (tt < 3) { PL_ACC(+, t + w2 + 8); PL_ACC(-, t - w2 + 8); }
            }
#undef PL_ACC
        }
        __syncthreads();
        if (g + 1 < 4) PL_COMMIT();
#pragma unroll
        for (int i = 0; i < 4; ++i) { const int e = tid + 512 * i; const ldsp gd = lds + GT + (e >> 4) * RS + (e & 15) * 16; *(ATT_LAS u32x2*)gd = (u32x2){greg[i][0], greg[i][1]}; *(ATT_LAS u32x2*)(gd + 8) = (u32x2){greg[i][2], greg[i][3]}; }
        f32x16 acc[2];
#pragma unroll
        for (int db = 0; db < 2; ++db)
#pragma unroll
            for (int i = 0; i < 16; ++i) acc[db][i] = 0.f;
#pragma unroll
        for (int ks = 0; ks < 8; ++ks) {
            const bf16x8 bfrag = *(const ATT_LAS bf16x8*)(lds + PL + tok * 256 + (((2 * ks + hh) ^ (tok & 15)) * 16));
#pragma unroll
            for (int db = 0; db < 2; ++db) acc[db] = ATT_MFMA(af[db][ks], bfrag, acc[db]);
        }
        __syncthreads();
        {
            const ldsp gl = lds + GT + tok * RS + (dhalf * 64 + 4 * hh) * 2, ol = lds + OT + tok * RS + (dhalf * 64 + 4 * hh) * 2;
#pragma unroll
            for (int db = 0; db < 2; ++db)
#pragma unroll
                for (int q = 0; q < 4; ++q) {
                    const u32x2 gq = *(const ATT_LAS u32x2*)(gl + (db * 32 + 8 * q) * 2); const float4 sc = scv[db][q];
                    const float g0 = __uint_as_float(gq.x << 16), g1 = __uint_as_float(gq.x & 0xffff0000u), g2 = __uint_as_float(gq.y << 16), g3 = __uint_as_float(gq.y & 0xffff0000u);
                    u32x2 w; w.x = pk2(acc[db][4 * q] * sc.x * g0, acc[db][4 * q + 1] * sc.y * g1); w.y = pk2(acc[db][4 * q + 2] * sc.z * g2, acc[db][4 * q + 3] * sc.w * g3);
                    *(ATT_LAS u32x2*)(ol + (db * 32 + 8 * q) * 2) = w;
                }
        }
        __syncthreads();
#pragma unroll
        for (int i = 0; i < 4; ++i) { const int e = tid + 512 * i; const ldsp od = lds + OT + (e >> 4) * RS + (e & 15) * 16; const u32x2 a0 = *(const ATT_LAS u32x2*)od, a1 = *(const ATT_LAS u32x2*)(od + 8);
            *(u32x4*)(mixed + (size_t)(t0 + (e >> 4)) * DMIX + 1024 + g * 128 + (e & 15) * 8) = (u32x4){a0.x, a0.y, a1.x, a1.y}; }
    }
#undef PL_ISSUE
#undef PL_COMMIT
}
}

__global__ void __launch_bounds__(NT, 2) mega(Params P) {
    extern __shared__ __attribute__((aligned(16))) unsigned char lds_raw[];
    float* lds = (float*)lds_raw;
    PG8_LAS unsigned char* lds3 = (PG8_LAS unsigned char*)lds_raw;
    cg::grid_group grid = cg::this_grid();
    unsigned char* ws = P.ws;
    float* biastbl = (float*)(ws + WS_BIAS);
    bf16_t* proj = (bf16_t*)(ws + WS_PROJ); bf16_t* mixed = (bf16_t*)(ws + WS_MIX); bf16_t* xb = (bf16_t*)(ws + WS_XB);
    volatile LAS unsigned* bst = (volatile LAS unsigned*)(lds3 + (LDS_BYTES - 64));
    if (threadIdx.x == 0) { bst[0] = 0u; bst[1] = 0u; }
    __syncthreads();
    const XcdBarrier bar = xcd_barrier_post((unsigned*)ws, bst);
    ph_prologue(P, lds);
    if (P.use_cg_sync) grid.sync();
    xcd_barrier(bar);
    for (int l = 0; l < 2; ++l) {
        {
            pg8::Gemm g{xb, (const bf16_t*)(ws + WS_WIN) + (size_t)l * DIN * DM, T, DIN, DM};
            pg8::StaticOrder S; S.init(T, DIN, (int)gridDim.x, (int)blockIdx.x, WGM_P1);
            EpiProj E{proj, (const float*)(ws + (l == 0 ? WS_RSS0 : WS_RSS1)), (const float2*)(ws + WS_ROT), lds3 + 131072 + 8192};
            pg8::gemm_phase<EpiProj, pg8::StaticOrder, true, true>(lds3, g, S, E);
        }
        xcd_barrier(bar);
        {
            unsigned* cst = (unsigned*)(ws + WS_CNT) + l * 64;
            const att::ldsp ldsa = (att::ldsp)lds_raw;
            const int bid = (int)blockIdx.x, G = (int)gridDim.x;
            for (int it = bid; it < 256; it += G) ret::ret_state_item(ldsa, it, proj, (const float*)(ws + WS_CONST) + l * 8, (bf16_t*)(ws + ret::WS_RST), cst);
            const int rho = G == 256 ? ((bid & 7) * 2 + (bid >> 7)) % 5 : 4;
            att::attn_phase(ldsa, 0, rho, proj, biastbl, (const float*)(ws + WS_CONST) + 16 + l, l, P.subln + l * 128, mixed);
            __syncthreads();
            if (G == 256) ret::ret_wait_states(cst, bid >> 4 & 3 | (bid >> 6) << 2, 16, 4); else ret::ret_wait_states(cst, 0, 1, 64);
            ret::ret_out_run(ldsa, bid, G, 1024, proj, (const float*)(ws + WS_CONST) + l * 8, (const bf16_t*)(ws + ret::WS_RST), mixed);
            __syncthreads();
            for (int it = bid; it < 256; it += G) pool::pool_item(ldsa, it, proj, (const bf16_t*)(ws + pool::WS_PW) + (size_t)l * 4 * 128 * 128, P.pool_scale + l * 512, mixed);
            __syncthreads();
            att::attn_phase(ldsa, rho, 4, proj, biastbl, (const float*)(ws + WS_CONST) + 16 + l, l, P.subln + l * 128, mixed);
            __syncthreads();
        }
        xcd_barrier(bar);
        {
            pg8::Gemm g{mixed, (const bf16_t*)(ws + WS_WOUT) + (size_t)l * DM * DMIX, T, DM, DMIX};
            pg8::StaticOrder S; S.init(T, DM, (int)gridDim.x, (int)blockIdx.x);
            if (l == 0) { EpiOut<0> E{P.out, xb, (float*)(ws + WS_RSS1), lds3 + 131072 + 8192}; pg8::gemm_phase<EpiOut<0>, pg8::StaticOrder, true, true>(lds3, g, S, E); }
            else if (gridDim.x == 256) { EpiOutFinal E{P.out, xb, P.fnw, (float*)(ws + WS_SLOT), (unsigned*)(ws + WS_PCNT), lds3 + 131072, lds3 + 131072 + 8192}; pg8::gemm_phase<EpiOutFinal, pg8::StaticOrder, true, true>(lds3, g, S, E); }
            else { EpiOut<1> E{P.out, xb, (float*)(ws + WS_RSS1), lds3 + 131072 + 8192}; pg8::gemm_phase<EpiOut<1>, pg8::StaticOrder, true, true>(lds3, g, S, E); }
        }
        if (l == 0 || gridDim.x != 256) xcd_barrier(bar);
    }
    if (gridDim.x != 256) ph_final_norm(P.out, P.fnw);
}

extern "C" void kernel_launch(void* const* d_in, const int* in_sizes, int n_in, void* d_out, int out_size, void* d_ws, size_t ws_size, hipStream_t stream) {
    static int grid_blocks = 0;
    if (!grid_blocks) {
        int dev = 0, cus = 0, per_cu = 0;
        (void)hipGetDevice(&dev);
        (void)hipDeviceGetAttribute(&cus, hipDeviceAttributeMultiprocessorCount, dev);
        (void)hipFuncSetAttribute((const void*)mega, hipFuncAttributeMaxDynamicSharedMemorySize, LDS_BYTES);
        (void)hipOccupancyMaxActiveBlocksPerMultiprocessor(&per_cu, (const void*)mega, NT, LDS_BYTES);
        if (per_cu < 1) per_cu = 1;
        grid_blocks = 256;
        if (cus * per_cu < 256) fprintf(stderr, "kernel_launch: device capacity %d x %d < 256 workgroups: the cooperative launch will be rejected\n", cus, per_cu);
    }
    Params p{};
    p.x = (const float*)d_in[0]; p.norm_w = (const float*)d_in[1]; p.w_in = (const float*)d_in[2]; p.diff_lambda = (const float*)d_in[3];
    p.subln = (const float*)d_in[4]; p.decay = (const float*)d_in[5]; p.pool_w = (const float*)d_in[6]; p.pool_scale = (const float*)d_in[7];
    p.w_out = (const float*)d_in[8]; p.rel_bias = (const float*)d_in[9]; p.fnw = (const float*)d_in[10];
    p.out = (float*)d_out; p.ws = (unsigned char*)d_ws;
    (void)hipMemsetAsync(d_ws, 0, 65536, stream);
    void* args[] = {&p};
    hipError_t e = hipLaunchCooperativeKernel((const void*)mega, dim3(grid_blocks), dim3(NT), args, LDS_BYTES, stream);
    if (e != hipSuccess) fprintf(stderr, "cooperative launch failed: %s (grid %d)\n", hipGetErrorString(e), grid_blocks);
}
```

```cpp
#include <hip/hip_runtime.h>
#include <hip/hip_cooperative_groups.h>
#include <cstdint>
#include <cstdio>
namespace cg = cooperative_groups;

constexpr int BATCH = 16, SEQ = 2048, DM = 1024, T = BATCH * SEQ;
constexpr int DIN = 4608, DMIX = 1536;
constexpr int C_AQ = 0, C_AK = 512, C_AV = 1024, C_AG = 1536, C_BQ = 2048, C_BK = 2304, C_BV = 2560, C_BG = 3072, C_CU = 3584, C_CG = 4096;
constexpr float EPS = 1e-6f;
constexpr int WGM_P1 = 4;
constexpr int NT = 512;
constexpr int LDS_BYTES = 163840;

typedef unsigned short bf16_t;
__device__ __forceinline__ bf16_t f2bf(float f) { unsigned u = __float_as_uint(f); u += 0x7fffu + ((u >> 16) & 1u); return (bf16_t)(u >> 16); }
__device__ __forceinline__ float bf2f(bf16_t b) { return __uint_as_float(((unsigned)b) << 16); }
__device__ __forceinline__ float bfr(float f) { return bf2f(f2bf(f)); }
__device__ __forceinline__ float silu(float v) { return v * __builtin_amdgcn_rcpf(1.f + __builtin_amdgcn_exp2f(v * -1.4426950408889634f)); }
__device__ __forceinline__ unsigned pk2(float lo, float hi) { return (unsigned)f2bf(lo) | ((unsigned)f2bf(hi) << 16); }

constexpr size_t MiB = 1u << 20;
constexpr size_t WS_CONST = 768 * 1024;
constexpr size_t WS_CNT = 49152;
constexpr size_t WS_XMIS = WS_CNT + 1024;
constexpr size_t WS_PCNT = 16384;
constexpr size_t WS_SLOT = 1 * MiB + 131072;
constexpr size_t WS_BIAS = 1 * MiB;
constexpr size_t WS_RSS0 = 2 * MiB;
constexpr size_t WS_RSS1 = 2 * MiB + 512 * 1024;
constexpr size_t WS_ROT = 3 * MiB;
constexpr size_t WS_WIN = 4 * MiB;
constexpr size_t WS_WOUT = 22 * MiB;
constexpr size_t WS_XB = 32 * MiB;
constexpr size_t WS_PROJ = 96 * MiB;
constexpr size_t WS_MIX = 384 * MiB;

struct Params {
    const float *x, *norm_w, *w_in, *diff_lambda, *subln, *decay, *pool_w, *pool_scale, *w_out, *rel_bias, *fnw;
    float* out; unsigned char* ws; int use_cg_sync; int pad_;
};
__device__ __forceinline__ void dma16(const void* base, unsigned voff, unsigned ldsaddr) {
    asm volatile("s_mov_b32 m0, %2\n\ts_nop 0\n\tglobal_load_lds_dwordx4 %0, %1" :: "v"(voff), "s"(base), "s"(ldsaddr) : "memory", "m0");
}

#define LAS __attribute__((address_space(3)))
#define XB_TMO      128
#define XB_XCNT(j)  (256  + 64 * (j))
#define XB_XSUB(j)  (1280 + 64 * (j))
#define XB_XGEN(j)  (2304 + 64 * (j))
#define XB_TOP      3328
#define XB_TOPGEN   3392
#define XCD_BAR_WORDS 3456
#define XB_SPIN_CAP (1u << 18)

__device__ __forceinline__ unsigned xb_ld(unsigned* p)              { return __hip_atomic_load(p, __ATOMIC_RELAXED, __HIP_MEMORY_SCOPE_AGENT); }
__device__ __forceinline__ unsigned xb_add(unsigned* p, unsigned v) { return __hip_atomic_fetch_add(p, v, __ATOMIC_RELAXED, __HIP_MEMORY_SCOPE_AGENT); }
__device__ __forceinline__ unsigned xb_xcc_id() { return (unsigned)__builtin_amdgcn_s_getreg((3 << 11) | 20) & 0xFu; }
#define XB_SPIN(cond, bar) do { unsigned _sp = 0; while (cond) { __builtin_amdgcn_s_sleep(1); \
    if ((++_sp & 255u) == 0u) { if (xb_ld(&(bar)[XB_TMO])) break; if (_sp > XB_SPIN_CAP) { atomicAdd(&(bar)[XB_TMO], 1u); break; } } } } while (0)

struct XcdBarrier {
    unsigned* bar; unsigned x;
    volatile LAS unsigned* st;
};

__device__ __forceinline__ XcdBarrier xcd_barrier_post(unsigned* bar, volatile LAS unsigned* st) {
    XcdBarrier b; b.bar = bar; b.x = xb_xcc_id(); b.st = st;
    if (threadIdx.x == 0) (void)xb_add(&bar[XB_XCNT(b.x)], 1u);
    return b;
}
__device__ __forceinline__ void xcd_barrier_complete(unsigned* bar, unsigned x, unsigned& nloc, unsigned& nx) {
    const unsigned G = gridDim.x * gridDim.y * gridDim.z;
    unsigned sum, cnt, mine, sp = 0u;
    for (;;) {
        sum = 0u; cnt = 0u; mine = 0u;
#pragma unroll
        for (unsigned j = 0; j < 16; ++j) { const unsigned c = xb_ld(&bar[XB_XCNT(j)]); sum += c; cnt += (c > 0u) ? 1u : 0u; mine = (j == x) ? c : mine; }
        if (sum == G) break;
        __builtin_amdgcn_s_sleep(1);
        if ((++sp & 255u) == 0u) { if (xb_ld(&bar[XB_TMO])) break; if (sp > XB_SPIN_CAP) { atomicAdd(&bar[XB_TMO], 1u); break; } }
    }
    nloc = mine > 0u ? mine : 1u; nx = cnt > 0u ? cnt : 1u;
}

__device__ __forceinline__ void xcd_barrier(const XcdBarrier& b) {
    asm volatile("s_waitcnt vmcnt(0)" ::: "memory");
    __syncthreads();
    if (threadIdx.x == 0) {
        unsigned* bar = b.bar;
        unsigned bx_ = b.x; asm volatile("" : "+s"(bx_));
        __builtin_amdgcn_s_waitcnt(0);
        unsigned nloc = b.st[0], nx = b.st[1];
        if (nloc == 0u) { xcd_barrier_complete(bar, bx_, nloc, nx); b.st[0] = nloc; b.st[1] = nx; }
        const unsigned old = xb_add(&bar[XB_XSUB(bx_)], 1u);
        const unsigned gen = old / nloc;
        if (old + 1u == (gen + 1u) * nloc) {
            __builtin_amdgcn_fence(__ATOMIC_RELEASE, "agent");
            asm volatile("s_waitcnt vmcnt(0)" ::: "memory");
            const unsigned og = xb_add(&bar[XB_TOP], 1u);
            const unsigned tg = og / nx;
            if (og + 1u == (tg + 1u) * nx) xb_add(&bar[XB_TOPGEN], 1u);
            else XB_SPIN(xb_ld(&bar[XB_TOPGEN]) == tg, bar);
            __builtin_amdgcn_fence(__ATOMIC_ACQUIRE, "agent");
            xb_add(&bar[XB_XGEN(bx_)], 1u);
            asm volatile("s_waitcnt vmcnt(0)" ::: "memory");
        } else {
            XB_SPIN(xb_ld(&bar[XB_XGEN(bx_)]) == gen, bar);
            __builtin_amdgcn_fence(__ATOMIC_ACQUIRE, "agent");
            asm volatile("s_waitcnt vmcnt(0)" ::: "memory");
        }
    }
    __syncthreads();
}

namespace pg8 {
#define PG8_LAS __attribute__((address_space(3)))
typedef unsigned short bf16_t;
typedef short bf16x8 __attribute__((ext_vector_type(8)));
typedef float f32x4 __attribute__((ext_vector_type(4)));
typedef unsigned u32x4 __attribute__((ext_vector_type(4)));
constexpr int BM = 256, BK = 64, HALF = 128, HTB = HALF * BK * 2  , STAGE_BYTES = 8 * HTB, NXCD = 8, WGM = 8;

__host__ __device__ __forceinline__ int lds_byte(int r, int c) { const int st = (r >> 4) * 2 + (c >> 5), rr = r & 15, cc = c & 31, ob = rr * 64 + cc * 2; return st * 1024 + (ob ^ (((ob >> 9) & 1) << 5)); }
__host__ __device__ __forceinline__ void stage_rc(int b, int& R, int& C) { const int st = b / 1024, sb = b % 1024, swz = sb ^ (((sb >> 9) & 1) << 5); R = (st >> 1) * 16 + swz / 64; C = (st & 1) * 32 + (swz % 64) / 2; }
__host__ __device__ __forceinline__ int perm32(int rho) { const int n = rho >> 4, i = rho & 15; return 8 * (i >> 2) + 4 * n + (i & 3); }

struct Unit { int pm, pn; };
struct Gemm { const bf16_t* A; const bf16_t* Bt; int M, N, K; };

struct StaticOrder {
    int nM, nN, nwg, G, c, wgm;
    __host__ __device__ void init(int M, int N, int G_, int c_, int wgm_ = WGM) { nM = M / BM; nN = N / BM; nwg = nM * nN; G = G_; c = c_; wgm = wgm_; }
    __host__ __device__ bool next(int i, Unit& u) const {
        const long L = (long)i * G + c; if (L >= nwg) return false;
        int wgid = (int)L; { const int q = nwg / NXCD, r = nwg % NXCD, xcd = wgid % NXCD, off = wgid / NXCD; wgid = (xcd < r ? xcd * (q + 1) : r * (q + 1) + (xcd - r) * q) + off; }
        const int nig = wgm * nN, gid = wgid / nig, fm = gid * wgm, gsz = (nM - fm) < wgm ? (nM - fm) : wgm;
        u.pm = fm + ((wgid % nig) % gsz); u.pn = (wgid % nig) / gsz; return true;
    }
    __device__ __forceinline__ void a_ready(const Unit&) const {}
    __device__ __forceinline__ void done(const Unit&) const {}
};


__device__ __forceinline__ unsigned cvt_pk_bf16(float lo, float hi) { unsigned r; asm volatile("v_cvt_pk_bf16_f32 %0, %1, %2" : "=v"(r) : "v"(lo), "v"(hi)); return r; }
typedef float f32x2 __attribute__((ext_vector_type(2)));

template <class Epi, class Sched, bool ALIGN_EPI = false, bool SP2 = false>
__device__ __forceinline__ void gemm_phase(PG8_LAS unsigned char* lds, const Gemm g, const Sched& S, const Epi& E) {
    int tid_ = threadIdx.x; asm volatile("" : "+v"(tid_)); const int tid = tid_, wid = __builtin_amdgcn_readfirstlane(tid >> 6), lane = tid & 63, wr = wid >> 2, wc = wid & 3, fr = lane & 15, fq = lane >> 4;
    const int K = g.K, nt = K / BK;
    unsigned voffA[2], voffB[2];
#pragma unroll
    for (int i = 0; i < 2; ++i) { int R, C; stage_rc(tid * 16 + i * 8192, R, C); const int Rb = Epi::PERM ? ((R & ~31) + perm32(R & 31)) : R;
        voffA[i] = (unsigned)(R * K + C) * 2u; voffB[i] = (unsigned)(Rb * K + C) * 2u; }
    const size_t kstep = (size_t)(BK * 2);
    const size_t hstep = (size_t)HALF * K * 2;
    const size_t tstep = 2 * hstep;
    const unsigned ldsw = (unsigned)wid * 1024u;
    const int aoff = lds_byte(wr * 64 + fr, fq * 8), boff = lds_byte(wc * 32 + fr, fq * 8);
#define PG8_SA(b, h) (((b) * 2 + (h)) * HTB)
#define PG8_SB(b, h) ((4 + (b) * 2 + (h)) * HTB)
#define PG8_STAGE(bufoff, gbase, voff) do { _Pragma("unroll") for (int _i = 0; _i < 2; ++_i) \
        dma16((gbase), (voff)[_i], (unsigned)(size_t)(lds + (bufoff) + ldsw + _i * 8192)); } while (0)
#define PG8_LDA(dst, b, h) do { _Pragma("unroll") for (int m = 0; m < 4; ++m) _Pragma("unroll") for (int k = 0; k < 2; ++k) dst[m][k] = *(const PG8_LAS bf16x8*)(lds + PG8_SA(b, h) + aoff + m * 2048 + k * 1024); } while (0)
#define PG8_LDB(dst, b, h) do { _Pragma("unroll") for (int n = 0; n < 2; ++n) _Pragma("unroll") for (int k = 0; k < 2; ++k) dst[n][k] = *(const PG8_LAS bf16x8*)(lds + PG8_SB(b, h) + boff + n * 2048 + k * 1024); } while (0)
#define PG8_MMA(ai, bj, At, Bt) do { __builtin_amdgcn_s_setprio(1); _Pragma("unroll") for (int m = 0; m < 4; ++m) _Pragma("unroll") for (int n = 0; n < 2; ++n) _Pragma("unroll") for (int k = 0; k < 2; ++k) \
        acc[ai][bj][m][n] = __builtin_amdgcn_mfma_f32_16x16x32_bf16(Bt[n][k], At[m][k], acc[ai][bj][m][n], 0, 0, 0); __builtin_amdgcn_s_setprio(0); } while (0)
#define PG8_WAIT_V(n) asm volatile("s_waitcnt vmcnt(" #n ")" ::: "memory")
#define PG8_WAIT_L(n) asm volatile("s_waitcnt lgkmcnt(" #n ")" ::: "memory")
#define PG8_BAR __builtin_amdgcn_s_barrier()
#define PG8_SCHED __builtin_amdgcn_sched_barrier(0)
    Unit cur, nxt; int ui = 0;
    if (!S.next(0, cur)) return;
    f32x4 acc[2][2][4][2];
#pragma unroll
    for (int a = 0; a < 2; ++a)
#pragma unroll
        for (int b = 0; b < 2; ++b)
#pragma unroll
            for (int m = 0; m < 4; ++m)
#pragma unroll
                for (int n = 0; n < 2; ++n) acc[a][b][m][n] = (f32x4){0.f, 0.f, 0.f, 0.f};
    bf16x8 At[4][2], B0[2][2], B1[2][2];
    const char* cA = (const char*)g.A + (size_t)cur.pm * tstep; const char* cB = (const char*)g.Bt + (size_t)cur.pn * tstep;
    S.a_ready(cur);
    if constexpr (SP2) {
        PG8_STAGE(PG8_SB(0, 0), cB, voffB); PG8_STAGE(PG8_SB(0, 1), cB + hstep, voffB); PG8_STAGE(PG8_SA(0, 0), cA, voffA); PG8_STAGE(PG8_SA(0, 1), cA + hstep, voffA);
        if (wr == 1) PG8_BAR;
        PG8_WAIT_V(2); PG8_BAR;
        PG8_STAGE(PG8_SB(1, 0), cB + kstep, voffB); PG8_STAGE(PG8_SA(1, 0), cA + kstep, voffA); PG8_STAGE(PG8_SB(1, 1), cB + hstep + kstep, voffB);
        PG8_WAIT_V(6); PG8_BAR;
    } else {
        PG8_STAGE(PG8_SB(0, 0), cB, voffB); PG8_STAGE(PG8_SA(0, 0), cA, voffA); PG8_STAGE(PG8_SB(0, 1), cB + hstep, voffB); PG8_STAGE(PG8_SA(0, 1), cA + hstep, voffA);
        if (wr == 1) PG8_BAR;
        PG8_WAIT_V(4); PG8_BAR;
        PG8_STAGE(PG8_SB(1, 0), cB + kstep, voffB); PG8_STAGE(PG8_SA(1, 0), cA + kstep, voffA); PG8_STAGE(PG8_SB(1, 1), cB + hstep + kstep, voffB);
        PG8_WAIT_V(6); PG8_BAR;
    }
    for (;;) {
        const bool has_next = S.next(ui + 1, nxt);
        const char* nA = has_next ? (const char*)g.A + (size_t)nxt.pm * tstep : cA; const char* nB = has_next ? (const char*)g.Bt + (size_t)nxt.pn * tstep : cB;
        for (int t = 0; t < nt; t += 2) {
            const bool last = (t == nt - 2);
            const char* a1 = cA + (size_t)(t + 1) * kstep;
            const char* a2 = last ? nA : cA + (size_t)(t + 2) * kstep; const char* b2 = last ? nB : cB + (size_t)(t + 2) * kstep;
            const char* a3 = a2 + kstep; const char* b3 = b2 + kstep;
            if (last && has_next) S.a_ready(nxt);
            if constexpr (SP2) {
            PG8_LDB(B0, 0, 0); PG8_LDB(B1, 0, 1); PG8_SCHED; PG8_LDA(At, 0, 0); PG8_STAGE(PG8_SA(1, 1), a1 + hstep, voffA);
            PG8_WAIT_V(8); PG8_WAIT_L(0); PG8_BAR; PG8_MMA(0, 0, At, B0); PG8_MMA(0, 1, At, B1); PG8_BAR; PG8_SCHED;
            PG8_LDA(At, 0, 1); PG8_STAGE(PG8_SB(0, 0), b2, voffB); PG8_STAGE(PG8_SB(0, 1), b2 + hstep, voffB); PG8_STAGE(PG8_SA(0, 0), a2, voffA);
            PG8_WAIT_V(8); PG8_WAIT_L(0); PG8_BAR; PG8_MMA(1, 0, At, B0); PG8_MMA(1, 1, At, B1); PG8_BAR; PG8_SCHED;
            PG8_LDB(B0, 1, 0); PG8_LDB(B1, 1, 1); PG8_SCHED; PG8_LDA(At, 1, 0); PG8_STAGE(PG8_SA(0, 1), a2 + hstep, voffA);
            PG8_WAIT_V(8); PG8_WAIT_L(0); PG8_BAR; PG8_MMA(0, 0, At, B0); PG8_MMA(0, 1, At, B1); PG8_BAR; PG8_SCHED;
            PG8_LDA(At, 1, 1); PG8_STAGE(PG8_SB(1, 0), b3, voffB); PG8_STAGE(PG8_SB(1, 1), b3 + hstep, voffB); PG8_STAGE(PG8_SA(1, 0), a3, voffA);
            PG8_WAIT_V(8); PG8_WAIT_L(0); PG8_BAR; PG8_MMA(1, 0, At, B0); PG8_MMA(1, 1, At, B1); PG8_BAR; PG8_SCHED;
            } else {
            PG8_LDB(B0, 0, 0); PG8_SCHED; PG8_LDA(At, 0, 0); PG8_STAGE(PG8_SA(1, 1), a1 + hstep, voffA);
            PG8_WAIT_L(8); PG8_BAR; PG8_WAIT_L(0); PG8_MMA(0, 0, At, B0); PG8_BAR; PG8_SCHED;
            PG8_LDB(B1, 0, 1); PG8_STAGE(PG8_SB(0, 0), b2, voffB);
            PG8_BAR; PG8_WAIT_L(0); PG8_MMA(0, 1, At, B1); PG8_BAR;
            PG8_LDA(At, 0, 1); PG8_STAGE(PG8_SA(0, 0), a2, voffA);
            PG8_BAR; PG8_WAIT_L(0); PG8_MMA(1, 0, At, B0); PG8_BAR; PG8_SCHED;
            PG8_STAGE(PG8_SB(0, 1), b2 + hstep, voffB);
            PG8_WAIT_V(6); PG8_BAR; PG8_MMA(1, 1, At, B1); PG8_BAR;
            PG8_LDB(B0, 1, 0); PG8_SCHED; PG8_LDA(At, 1, 0); PG8_STAGE(PG8_SA(0, 1), a2 + hstep, voffA);
            PG8_WAIT_L(8); PG8_BAR; PG8_WAIT_L(0); PG8_MMA(0, 0, At, B0); PG8_BAR; PG8_SCHED;
            PG8_LDB(B1, 1, 1); PG8_STAGE(PG8_SB(1, 0), b3, voffB);
            PG8_BAR; PG8_WAIT_L(0); PG8_MMA(0, 1, At, B1); PG8_BAR;
            PG8_LDA(At, 1, 1); PG8_STAGE(PG8_SA(1, 0), a3, voffA);
            PG8_BAR; PG8_WAIT_L(0); PG8_MMA(1, 0, At, B0); PG8_BAR; PG8_SCHED;
            PG8_STAGE(PG8_SB(1, 1), b3 + hstep, voffB);
            PG8_WAIT_V(6); PG8_BAR; PG8_MMA(1, 1, At, B1); PG8_BAR;
            }
        }
        if constexpr (ALIGN_EPI) { if (wr == 0) PG8_BAR; }
        if constexpr (!Epi::AFTER_DRAIN) { E(acc, cur, wr, wc, fr, fq); S.done(cur); }
        if (!has_next) break;
#pragma unroll
        for (int a = 0; a < 2; ++a)
#pragma unroll
            for (int b = 0; b < 2; ++b)
#pragma unroll
                for (int m = 0; m < 4; ++m)
#pragma unroll
                    for (int n = 0; n < 2; ++n) acc[a][b][m][n] = (f32x4){0.f, 0.f, 0.f, 0.f};
        cur = nxt; cA = nA; cB = nB; ++ui;
        if constexpr (ALIGN_EPI) { if (wr == 1) PG8_BAR; }
    }
    PG8_WAIT_V(0);
    if constexpr (!ALIGN_EPI) { if (wr == 0) PG8_BAR; }
    PG8_BAR;
    if constexpr (Epi::AFTER_DRAIN) { E.fused(acc, cur, wr, wc, fr, fq, lds, wid, lane); S.done(cur); }
#undef PG8_SA
#undef PG8_SB
#undef PG8_STAGE
#undef PG8_LDA
#undef PG8_LDB
#undef PG8_MMA
#undef PG8_WAIT_V
#undef PG8_WAIT_L
#undef PG8_BAR
#undef PG8_SCHED
}
}

template <int LD> __device__ __forceinline__ void epi_put16(const pg8::u32x4& wa, const pg8::u32x4& wb, bf16_t* gbase, PG8_LAS unsigned char* sc, int fr, int fq, int lane) {
    *(PG8_LAS pg8::u32x4*)(sc + fr * 128 + ((fq ^ (fr & 7)) * 16)) = wa;
    *(PG8_LAS pg8::u32x4*)(sc + fr * 128 + (((4 + fq) ^ (fr & 7)) * 16)) = wb;
    asm volatile("s_waitcnt lgkmcnt(0)" ::: "memory");
    const int rr = lane >> 3, c = lane & 7;
    const pg8::u32x4 x0 = *(const PG8_LAS pg8::u32x4*)(sc + rr * 128 + ((c ^ (rr & 7)) * 16)), x1 = *(const PG8_LAS pg8::u32x4*)(sc + (rr + 8) * 128 + ((c ^ (rr & 7)) * 16));
    asm volatile("s_waitcnt lgkmcnt(0)" ::: "memory");
    *(pg8::u32x4*)(gbase + (size_t)rr * LD + c * 8) = x0; *(pg8::u32x4*)(gbase + (size_t)(rr + 8) * LD + c * 8) = x1;
}
__device__ __forceinline__ void epi_put32(const pg8::f32x4& va, const pg8::f32x4& vb, float* gbase, PG8_LAS unsigned char* sc, int fr, int fq, int lane) {
    *(PG8_LAS pg8::f32x4*)(sc + fr * 128 + (((2 * fq) ^ (fr & 7)) * 16)) = va;
    *(PG8_LAS pg8::f32x4*)(sc + fr * 128 + (((2 * fq + 1) ^ (fr & 7)) * 16)) = vb;
    asm volatile("s_waitcnt lgkmcnt(0)" ::: "memory");
    const int rr = lane >> 3, c = lane & 7;
    const pg8::f32x4 x0 = *(const PG8_LAS pg8::f32x4*)(sc + rr * 128 + ((c ^ (rr & 7)) * 16)), x1 = *(const PG8_LAS pg8::f32x4*)(sc + (rr + 8) * 128 + ((c ^ (rr & 7)) * 16));
    asm volatile("s_waitcnt lgkmcnt(0)" ::: "memory");
    *(pg8::f32x4*)(gbase + (size_t)rr * DM + c * 4) = x0; *(pg8::f32x4*)(gbase + (size_t)(rr + 8) * DM + c * 4) = x1;
}
struct EpiProj {
    static constexpr bool PERM = true, AFTER_DRAIN = false;
    bf16_t* O; const float* rowss; const float2* rot; PG8_LAS unsigned char* xs;
    __device__ __forceinline__ void operator()(const pg8::f32x4 (&acc)[2][2][4][2], const pg8::Unit& u, int wr, int wc, int fr, int fq) const {
        const int lane = fq * 16 + fr;
        PG8_LAS unsigned char* sc = xs + (wr * 4 + wc) * 2048;
        const int rowb = u.pm * 256 + wr * 64, colb = u.pn * 256 + wc * 64;
        const bool rotary = (u.pn == 8 || u.pn == 9);
        const bool gatep = (u.pn == 6 || u.pn == 7 || u.pn == 12 || u.pn == 13 || u.pn == 16 || u.pn == 17);
        float rsv[8];
#pragma unroll
        for (int i = 0; i < 8; ++i) rsv[i] = rowss[rowb + (i >> 2) * 128 + (i & 3) * 16 + fr];
#pragma unroll
        for (int ai = 0; ai < 2; ++ai)
#pragma unroll
            for (int m = 0; m < 4; ++m) {
                const int row = rowb + ai * 128 + m * 16 + fr;
                const float rs = rsqrtf(rsv[ai * 4 + m] * (1.f / DM) + EPS);
                pg8::f32x4 a0 = acc[ai][0][m][0] * rs, a1 = acc[ai][0][m][1] * rs, b0 = acc[ai][1][m][0] * rs, b1 = acc[ai][1][m][1] * rs;
                if (gatep) {
#pragma unroll
                    for (int j = 0; j < 4; ++j) { a0[j] = silu(a0[j]); a1[j] = silu(a1[j]); b0[j] = silu(b0[j]); b1[j] = silu(b1[j]); }
                }
                pg8::u32x4 w1, w2;
                if (rotary) {
                    const pg8::f32x4* cs = (const pg8::f32x4*)(rot + (size_t)(row & (SEQ - 1)) * 32 + 8 * fq);
                    const pg8::f32x4 c01 = cs[0], c23 = cs[1], c45 = cs[2], c67 = cs[3];
                    w1.x = pg8::cvt_pk_bf16(a0[0] * c01[0] - b0[0] * c01[1], a0[1] * c01[2] - b0[1] * c01[3]); w2.x = pg8::cvt_pk_bf16(a0[0] * c01[1] + b0[0] * c01[0], a0[1] * c01[3] + b0[1] * c01[2]);
                    w1.y = pg8::cvt_pk_bf16(a0[2] * c23[0] - b0[2] * c23[1], a0[3] * c23[2] - b0[3] * c23[3]); w2.y = pg8::cvt_pk_bf16(a0[2] * c23[1] + b0[2] * c23[0], a0[3] * c23[3] + b0[3] * c23[2]);
                    w1.z = pg8::cvt_pk_bf16(a1[0] * c45[0] - b1[0] * c45[1], a1[1] * c45[2] - b1[1] * c45[3]); w2.z = pg8::cvt_pk_bf16(a1[0] * c45[1] + b1[0] * c45[0], a1[1] * c45[3] + b1[1] * c45[2]);
                    w1.w = pg8::cvt_pk_bf16(a1[2] * c67[0] - b1[2] * c67[1], a1[3] * c67[2] - b1[3] * c67[3]); w2.w = pg8::cvt_pk_bf16(a1[2] * c67[1] + b1[2] * c67[0], a1[3] * c67[3] + b1[3] * c67[2]);
                } else {
                    w1.x = pg8::cvt_pk_bf16(a0[0], a0[1]); w1.y = pg8::cvt_pk_bf16(a0[2], a0[3]); w1.z = pg8::cvt_pk_bf16(a1[0], a1[1]); w1.w = pg8::cvt_pk_bf16(a1[2], a1[3]);
                    w2.x = pg8::cvt_pk_bf16(b0[0], b0[1]); w2.y = pg8::cvt_pk_bf16(b0[2], b0[3]); w2.z = pg8::cvt_pk_bf16(b1[0], b1[1]); w2.w = pg8::cvt_pk_bf16(b1[2], b1[3]);
                }
                epi_put16<DIN>(w1, w2, O + (size_t)(rowb + ai * 128 + m * 16) * DIN + colb, sc, fr, fq, lane);
            }
    }
};
template <int MODE> struct EpiOut {
    static constexpr bool PERM = true, AFTER_DRAIN = false;
    float* out; bf16_t* xb; float* rss; PG8_LAS unsigned char* xs;
    __device__ __forceinline__ void operator()(const pg8::f32x4 (&acc)[2][2][4][2], const pg8::Unit& u, int wr, int wc, int fr, int fq) const {
        const int lane = fq * 16 + fr;
        PG8_LAS unsigned char* sc = xs + (wr * 4 + wc) * 2048;
        const int rowb = u.pm * 256 + wr * 64, colb = u.pn * 256 + wc * 64;
        pg8::u32x4 xrv[8][2];
#pragma unroll
        for (int i = 0; i < 8; ++i)
#pragma unroll
            for (int bj = 0; bj < 2; ++bj) xrv[i][bj] = *(const pg8::u32x4*)(xb + (size_t)(rowb + (i >> 2) * 128 + (i & 3) * 16 + fr) * DM + colb + 8 * fq + bj * 32);
#pragma unroll
        for (int ai = 0; ai < 2; ++ai)
#pragma unroll
            for (int m = 0; m < 4; ++m) {
                const int row = rowb + ai * 128 + m * 16 + fr;
                float ss = 0.f; pg8::u32x4 w[2]; pg8::f32x4 v[2][2];
#pragma unroll
                for (int bj = 0; bj < 2; ++bj) {
                    const pg8::u32x4 xr = xrv[ai * 4 + m][bj];
                    pg8::f32x4 v0 = acc[ai][bj][m][0], v1 = acc[ai][bj][m][1];
                    v0[0] += __uint_as_float(xr.x << 16); v0[1] += __uint_as_float(xr.x & 0xffff0000u); v0[2] += __uint_as_float(xr.y << 16); v0[3] += __uint_as_float(xr.y & 0xffff0000u);
                    v1[0] += __uint_as_float(xr.z << 16); v1[1] += __uint_as_float(xr.z & 0xffff0000u); v1[2] += __uint_as_float(xr.w << 16); v1[3] += __uint_as_float(xr.w & 0xffff0000u);
                    v[bj][0] = v0; v[bj][1] = v1;
                    if (MODE == 0) {
                        w[bj].x = pg8::cvt_pk_bf16(v0[0], v0[1]); w[bj].y = pg8::cvt_pk_bf16(v0[2], v0[3]); w[bj].z = pg8::cvt_pk_bf16(v1[0], v1[1]); w[bj].w = pg8::cvt_pk_bf16(v1[2], v1[3]);
                        const float r0 = __uint_as_float(w[bj].x << 16), r1 = __uint_as_float(w[bj].x & 0xffff0000u), r2 = __uint_as_float(w[bj].y << 16), r3 = __uint_as_float(w[bj].y & 0xffff0000u);
                        const float r4 = __uint_as_float(w[bj].z << 16), r5 = __uint_as_float(w[bj].z & 0xffff0000u), r6 = __uint_as_float(w[bj].w << 16), r7 = __uint_as_float(w[bj].w & 0xffff0000u);
                        ss += (r0 * r0 + r1 * r1) + (r2 * r2 + r3 * r3) + (r4 * r4 + r5 * r5) + (r6 * r6 + r7 * r7);
                    }
                }
                if (MODE == 0) {
                    epi_put16<DM>(w[0], w[1], xb + (size_t)(rowb + ai * 128 + m * 16) * DM + colb, sc, fr, fq, lane);
                    ss += __shfl_xor(ss, 16); ss += __shfl_xor(ss, 32); if (fq == 0) atomicAdd(rss + row, ss);
                } else {
#pragma unroll
                    for (int bj = 0; bj < 2; ++bj) epi_put32(v[bj][0], v[bj][1], out + (size_t)(rowb + ai * 128 + m * 16) * DM + colb + bj * 32, sc, fr, fq, lane);
                }
            }
    }
};
struct EpiOutFinal {
    static constexpr bool PERM = true, AFTER_DRAIN = false;
    float* out; const bf16_t* xb; const float* fnw; float* slots; unsigned* cnt; PG8_LAS unsigned char* xl; PG8_LAS unsigned char* xs;
    __device__ __forceinline__ void operator()(const pg8::f32x4 (&acc_)[2][2][4][2], const pg8::Unit& u, int wr, int wc, int fr, int fq) const {
        pg8::f32x4 (&acc)[2][2][4][2] = const_cast<pg8::f32x4 (&)[2][2][4][2]>(acc_);
        int tid_ = threadIdx.x; asm volatile("" : "+v"(tid_));
        const int tid = tid_, lane = tid & 63, wid = __builtin_amdgcn_readfirstlane(tid >> 6);
        PG8_LAS float* Pl = (PG8_LAS float*)xl; PG8_LAS float* Sl = (PG8_LAS float*)(xl + 4096); PG8_LAS unsigned* flag = (PG8_LAS unsigned*)(xl + 5120);
        const int row0 = u.pm * 256 + wr * 64 + fr, col0 = u.pn * 256 + wc * 64 + 8 * fq;
        PG8_LAS unsigned char* sc = xs + (wr * 4 + wc) * 2048;
#pragma unroll
        for (int ai = 0; ai < 2; ++ai)
#pragma unroll
            for (int m = 0; m < 4; ++m) {
                const size_t off = (size_t)(row0 + ai * 128 + m * 16) * DM + col0;
                float ss = 0.f;
#pragma unroll
                for (int bj = 0; bj < 2; ++bj) {
                    const pg8::u32x4 xr = *(const pg8::u32x4*)(xb + off + bj * 32);
                    pg8::f32x4& v0 = acc[ai][bj][m][0]; pg8::f32x4& v1 = acc[ai][bj][m][1];
                    v0[0] += __uint_as_float(xr.x << 16); v0[1] += __uint_as_float(xr.x & 0xffff0000u); v0[2] += __uint_as_float(xr.y << 16); v0[3] += __uint_as_float(xr.y & 0xffff0000u);
                    v1[0] += __uint_as_float(xr.z << 16); v1[1] += __uint_as_float(xr.z & 0xffff0000u); v1[2] += __uint_as_float(xr.w << 16); v1[3] += __uint_as_float(xr.w & 0xffff0000u);
                    ss += (v0[0] * v0[0] + v0[1] * v0[1]) + (v0[2] * v0[2] + v0[3] * v0[3]) + (v1[0] * v1[0] + v1[1] * v1[1]) + (v1[2] * v1[2] + v1[3] * v1[3]);
                }
                ss += __shfl_xor(ss, 16); ss += __shfl_xor(ss, 32);
                if (fq == 0) Pl[(ai * 128 + wr * 64 + m * 16 + fr) * 4 + wc] = ss;
            }
        asm volatile("s_waitcnt lgkmcnt(0)\n\ts_barrier" ::: "memory");
        if (tid < 256) {
            const float s = (Pl[tid * 4] + Pl[tid * 4 + 1]) + (Pl[tid * 4 + 2] + Pl[tid * 4 + 3]);
            __hip_atomic_store(slots + ((size_t)(u.pm * 256 + tid) * 4 + u.pn), s, __ATOMIC_RELAXED, __HIP_MEMORY_SCOPE_AGENT);
        }
        asm volatile("s_waitcnt vmcnt(0)" ::: "memory");
        if (lane == 0) __hip_atomic_fetch_add(cnt + 64 * u.pm, 1u, __ATOMIC_RELAXED, __HIP_MEMORY_SCOPE_AGENT);
        if (wid == 0) {
            unsigned sp = 0;
            while ((unsigned)__builtin_amdgcn_readfirstlane(__hip_atomic_load(cnt + 64 * u.pm, __ATOMIC_RELAXED, __HIP_MEMORY_SCOPE_AGENT)) < 32u && ++sp < (1u << 22)) __builtin_amdgcn_s_sleep(1);
            __builtin_amdgcn_fence(__ATOMIC_ACQUIRE, "agent");
            if (lane == 0) flag[0] = sp;
        }
        asm volatile("s_waitcnt vmcnt(0) lgkmcnt(0)\n\ts_barrier" ::: "memory");
        if (tid < 256) {
            const float* sl = slots + (size_t)(u.pm * 256 + tid) * 4; float t = 0.f;
#pragma unroll
            for (int k = 0; k < 4; ++k) t += __hip_atomic_load(sl + k, __ATOMIC_RELAXED, __HIP_MEMORY_SCOPE_AGENT);
            Sl[tid] = rsqrtf(t * (1.f / DM) + EPS);
        }
        asm volatile("s_waitcnt vmcnt(0) lgkmcnt(0)\n\ts_barrier" ::: "memory");
        pg8::f32x4 w0[2], w1[2];
#pragma unroll
        for (int bj = 0; bj < 2; ++bj) { w0[bj] = *(const pg8::f32x4*)(fnw + col0 + bj * 32); w1[bj] = *(const pg8::f32x4*)(fnw + col0 + bj * 32 + 4); }
        const int lane_ = fq * 16 + fr;
#pragma unroll
        for (int ai = 0; ai < 2; ++ai)
#pragma unroll
            for (int m = 0; m < 4; ++m) {
                const int rl = ai * 128 + wr * 64 + m * 16 + fr; const float rs = Sl[rl];
#pragma unroll
                for (int bj = 0; bj < 2; ++bj)
                    epi_put32(acc[ai][bj][m][0] * rs * w0[bj], acc[ai][bj][m][1] * rs * w1[bj], out + (size_t)(u.pm * 256 + ai * 128 + wr * 64 + m * 16) * DM + u.pn * 256 + wc * 64 + bj * 32, sc, fr, fq, lane_);
            }
    }
};

__device__ __forceinline__ void ph_bias_table(const float* rel_bias, float* tbl, int gtid, int gsize) {
    for (int i = gtid; i < 4096; i += gsize) {
        int rel = i - 2048;
        int ret = rel > 0 ? 16 : 0;
        int n = rel < 0 ? -rel : rel;
        float nf = (float)(n > 1 ? n : 1);
        float lg = logf(nf / 8.0f) / 2.7725887298583984f * 8.0f;
        int large = 8 + (int)lg;
        if (large > 15) large = 15;
        int b = ret + (n < 8 ? n : large);
        for (int h = 0; h < 4; ++h) tbl[h * 4096 + i] = rel_bias[b * 4 + h] * 1.4426950408889634f;
    }
}
__device__ __forceinline__ void p0_transpose_item(const float* W, const float* sc, int K, int N, bf16_t* WT, LAS float* scr, int item, int lane, int nlim, float nscale, bool perm, bool frag = false) {
    const int nblk = N / 32, kb = item / nblk, nb = item % nblk, k0 = 64 * kb, n0 = 32 * nb; const float ns = n0 < nlim ? nscale : 1.f;
    int n0o = n0; if (perm) { const int tb = n0 & ~255, rel = n0 & 255; n0o = tb + ((rel >> 5) & 1) * 128 + (rel >> 6) * 32; }
    float v[32];
#pragma unroll
    for (int i = 0; i < 32; ++i) v[i] = W[(size_t)(k0 + 2 * i + (lane >> 5)) * N + n0 + (lane & 31)];
    if (sc) {
#pragma unroll
        for (int i = 0; i < 32; ++i) v[i] *= sc[k0 + 2 * i + (lane >> 5)] * ns;
    }
#pragma unroll
    for (int i = 0; i < 32; ++i) scr[(2 * i + (lane >> 5)) * 33 + (lane & 31)] = v[i];
    asm volatile("s_waitcnt lgkmcnt(0)" ::: "memory");
    const int c = lane & 7;
#pragma unroll
    for (int j = 0; j < 4; ++j) { const int n = (lane >> 3) + 8 * j; const LAS float* s = scr + (8 * c) * 33 + n;
        uint4 o; o.x = pk2(s[0 * 33], s[1 * 33]); o.y = pk2(s[2 * 33], s[3 * 33]); o.z = pk2(s[4 * 33], s[5 * 33]); o.w = pk2(s[6 * 33], s[7 * 33]);
        if (frag) { const int d = n0 + n, kc = (k0 >> 3) + c; *(uint4*)(WT + (size_t)(((((d >> 5) * 8 + (kc >> 1)) * 2 + (kc & 1)) * 32 + (d & 31)) * 8)) = o; }
        else *(uint4*)(WT + (size_t)(n0o + n) * K + k0 + 8 * c) = o; }
    asm volatile("s_waitcnt lgkmcnt(0)" ::: "memory");
}
__device__ __forceinline__ void ph_prologue(const Params& P, float* lds) {
    unsigned char* ws = P.ws;
    int tid_ = threadIdx.x; asm volatile("" : "+v"(tid_));
    const int lane = tid_ & 63, wave = tid_ >> 6;
    const int gw = blockIdx.x * (NT / 64) + wave, ngw = gridDim.x * (NT / 64);
    if (blockIdx.x == 0 && tid_ < 18) {
        float* ct = (float*)(ws + WS_CONST);
        if (tid_ < 16) ct[tid_] = -log1pf(expf(-P.decay[tid_])) * 1.4426950408889634f;
        else { const int l = tid_ - 16; const float* dl = P.diff_lambda + l * 256; float s01 = 0.f, s23 = 0.f;
            for (int d = 0; d < 64; ++d) { s01 += dl[d] * dl[64 + d]; s23 += dl[128 + d] * dl[192 + d]; }
            ct[16 + l] = expf(s01) - expf(s23) + (l == 0 ? 0.2f : 0.35550907f); }
    }
    ph_bias_table(P.rel_bias, (float*)(ws + WS_BIAS), blockIdx.x * NT + tid_, gridDim.x * NT);
    {
        float2* rot = (float2*)(ws + WS_ROT);
        for (int i = blockIdx.x * NT + tid_; i < SEQ * 32; i += gridDim.x * NT) {
            const int pr = i & 31, pos = i >> 5;
            const float theta = 1.0f / powf(10000.0f, (float)pr / 31.0f);
            const float ang = (float)pos * theta;
            rot[i] = make_float2(cosf(ang), sinf(ang));
        }
    }
    LAS float* scr = (LAS float*)lds + wave * (64 * 33);
    constexpr int I_IN = (DM / 64) * (DIN / 32), I_OUT = (DMIX / 64) * (DM / 32);
    constexpr int I_PW = (128 / 64) * (128 / 32);
    for (int it = gw; it < 8 * I_PW; it += ngw) { const int mtx = it / I_PW; p0_transpose_item(P.pool_w + (size_t)mtx * 128 * 128, nullptr, 128, 128, (bf16_t*)(ws + (28u << 20)) + (size_t)mtx * 128 * 128, scr, it % I_PW, lane, 0, 1.f, false, true); }
    for (int it = gw; it < 2 * (I_IN + I_OUT); it += ngw) {
        int r = it;
        if (r < 2 * I_IN) { const int l = r / I_IN; r -= l * I_IN; p0_transpose_item(P.w_in + (size_t)l * DM * DIN, P.norm_w + l * DM, DM, DIN, (bf16_t*)(ws + WS_WIN) + (size_t)l * DIN * DM, scr, r, lane, 512, 0.125f * 1.4426950408889634f, true); }
        else { r -= 2 * I_IN; const int l = r / I_OUT; r -= l * I_OUT; p0_transpose_item(P.w_out + (size_t)l * DMIX * DM, nullptr, DMIX, DM, (bf16_t*)(ws + WS_WOUT) + (size_t)l * DM * DMIX, scr, r, lane, 0, 1.f, true); }
    }
    float* rss0 = (float*)(ws + WS_RSS0); float* rss1 = (float*)(ws + WS_RSS1); bf16_t* xb = (bf16_t*)(ws + WS_XB);
    for (int row0 = gw * 4; row0 < T; row0 += ngw * 4) {
        float4 v[4][4];
#pragma unroll
        for (int q = 0; q < 4; ++q) { const float4* p = (const float4*)(P.x + (size_t)(row0 + q) * DM);
#pragma unroll
            for (int j = 0; j < 4; ++j) v[q][j] = p[lane + 64 * j]; }
#pragma unroll
        for (int q = 0; q < 4; ++q) {
            uint2* o = (uint2*)(xb + (size_t)(row0 + q) * DM);
            float s = 0.f;
#pragma unroll
            for (int j = 0; j < 4; ++j) { const float4 t = v[q][j]; s += t.x * t.x + t.y * t.y + t.z * t.z + t.w * t.w; uint2 w; w.x = pk2(t.x, t.y); w.y = pk2(t.z, t.w); o[lane + 64 * j] = w; }
#pragma unroll
            for (int of = 32; of > 0; of >>= 1) s += __shfl_xor(s, of);
            if (lane == 0) { rss0[row0 + q] = s; rss1[row0 + q] = 0.f; }
        }
    }
}

__device__ __forceinline__ void ph_final_norm(float* x, const float* w) {
    int tid_ = threadIdx.x; asm volatile("" : "+v"(tid_));
    const int lane = tid_ & 63, gw = blockIdx.x * (NT / 64) + (tid_ >> 6), ngw = gridDim.x * (NT / 64);
    for (int row = gw; row < T; row += ngw) {
        float4* p = (float4*)(x + (size_t)row * DM);
        float4 v[4]; float s = 0.f;
        for (int j = 0; j < 4; ++j) { v[j] = p[lane + 64 * j]; s += v[j].x * v[j].x + v[j].y * v[j].y + v[j].z * v[j].z + v[j].w * v[j].w; }
        for (int o = 32; o > 0; o >>= 1) s += __shfl_xor(s, o);
        const float r = rsqrtf(s * (1.f / DM) + EPS);
        for (int j = 0; j < 4; ++j) { float4 ww = ((const float4*)w)[lane + 64 * j]; float4 o4; o4.x = v[j].x * r * ww.x; o4.y = v[j].y * r * ww.y; o4.z = v[j].z * r * ww.z; o4.w = v[j].w * r * ww.w; p[lane + 64 * j] = o4; }
    }
}


namespace att {
#define ATT_LAS __attribute__((address_space(3)))
typedef short bf16x8 __attribute__((ext_vector_type(8)));
typedef short s16x4 __attribute__((ext_vector_type(4)));
typedef float f32x16 __attribute__((ext_vector_type(16)));
typedef ATT_LAS unsigned char* ldsp;
typedef unsigned u32x4 __attribute__((ext_vector_type(4)));
__device__ __forceinline__ int crow(int reg, int hh) { return (reg & 3) + 8 * (reg >> 2) + 4 * hh; }
__device__ __forceinline__ s16x4 vtr(ldsp p) { return __builtin_bit_cast(s16x4, __builtin_amdgcn_ds_read_tr16_b64_v4i16((ATT_LAS s16x4*)p)); }
typedef float f32x2_t __attribute__((ext_vector_type(2))); typedef __bf16 bf16x2_t __attribute__((ext_vector_type(2)));
__device__ __forceinline__ unsigned cvtpk(float lo, float hi) { f32x2_t v = {lo, hi}; bf16x2_t b = __builtin_convertvector(v, bf16x2_t); return __builtin_bit_cast(unsigned, b); }
#define ATT_MFMA(a, b, c) __builtin_amdgcn_mfma_f32_32x32x16_bf16((a), (b), (c), 0, 0, 0)

constexpr float ATT_THR = 6.0f;
__device__ __forceinline__ float max3f(float a, float b, float c) { float r; asm("v_max3_f32 %0, %1, %2, %3" : "=v"(r) : "v"(a), "v"(b), "v"(c)); return r; }
__device__ __forceinline__ float rowmax32(const f32x16& p0, const f32x16& p1) {
    float a = max3f(p0[0], p0[1], p1[0]), b = max3f(p0[2], p0[3], p1[1]); a = max3f(a, p1[2], p1[3]);
#pragma unroll
    for (int i = 4; i < 16; i += 4) { a = max3f(a, p0[i], p0[i + 1]); b = max3f(b, p0[i + 2], p0[i + 3]); a = max3f(a, p1[i], p1[i + 1]); b = max3f(b, p1[i + 2], p1[i + 3]); }
    float m = max3f(a, b, b);
    auto rr = __builtin_amdgcn_permlane32_swap(__float_as_uint(m), __float_as_uint(m), false, false);
    return max3f(__uint_as_float(rr[0]), __uint_as_float(rr[1]), m);
}

#define ATT_WAIT_BAR(N) asm volatile("s_waitcnt vmcnt(" #N ") lgkmcnt(0)\n\ts_barrier" ::: "memory")
#define ATT_ISSUE_K(pb, t) do { _Pragma("unroll") for (int i_ = 0; i_ < 2; ++i_) dma16((pb), ksrc[i_] + (unsigned)(t) * (128u * DIN), (unsigned)(size_t)(lds + KR + ((t) & 3) * 16384 + wid * 2048 + i_ * 1024)); } while (0)
#define ATT_ISSUE_V(pb, t) do { _Pragma("unroll") for (int i_ = 0; i_ < 2; ++i_) dma16((pb), vsrc[i_] + (unsigned)(t) * (128u * DIN), (unsigned)(size_t)(lds + VR + ((t) & 3) * 16384 + wid * 2048 + i_ * 1024)); } while (0)
#define ATT_LANE_SETUP() \
    int tid_ = threadIdx.x; asm volatile("" : "+v"(tid_)); \
    const int tid = tid_, lane = tid & 63, wid = __builtin_amdgcn_readfirstlane(tid >> 6), r = lane & 31, hh = lane >> 5; \
    const int mp = wid & 1, qs = wid >> 1, q0 = qblk * 128 + qs * 32; \
    unsigned ksrc[2], vsrc[2]; \
    _Pragma("unroll") for (int i = 0; i < 2; ++i) { \
        const int krow = 8 * wid + 4 * i + (lane >> 4), kc = (lane & 15) ^ (krow & 15); \
        ksrc[i] = 2u * (unsigned)(krow * DIN + C_AK + h * 128 + kc * 8); \
        const int vrow = 8 * wid + ((lane >> 2) & 7), vc = 4 * (2 * i + (lane >> 5)) + (lane & 3); \
        vsrc[i] = 2u * (unsigned)(vrow * DIN + C_AV + h * 128 + vc * 8); }
template <int TRAIL>
__device__ __forceinline__ void attn_run(ldsp lds, int i_lo, int i_hi, int xg  , int qblk, const bf16_t* __restrict__ proj, const float* __restrict__ tbl2, float lam, int layer, const float* __restrict__ subln_w, bf16_t* __restrict__ mixed) {
    if (i_lo >= i_hi) return;
    const int h = xg & 3;
    constexpr int NTILE = SEQ / 64;
    constexpr int KR = 0, VR = 65536, TBO = 131072, XB = 133120;
    __syncthreads();
    {
        ATT_LANE_SETUP();
        (void)r; (void)hh; (void)mp; (void)q0;
        const float tv = tbl2[h * 4096 + 2048 - 256 + tid]; ATT_LAS float* tbw = (ATT_LAS float*)(lds + TBO); tbw[tid] = tv;
        const bf16_t* pb0 = proj + (size_t)((i_lo * 16 + xg) >> 2) * SEQ * DIN;
        ATT_ISSUE_K(pb0, 0); ATT_ISSUE_V(pb0, 0); ATT_ISSUE_K(pb0, 1); ATT_ISSUE_V(pb0, 1);
    }
#define ATT_SIDE(t) (((t) * 64 + 63 - q0 <= -128) ? 0 : (((t) * 64 - (q0 + 31) >= 128) ? 2 : 1))
#define ATT_QK(P0, P1, t) do { const ldsp kp_ = lds + ((t) & 3) * 16384 + kbase; \
        f32x16 cin_; { const float c_ = (ATT_SIDE(t) == 2 ? bias_pos : bias_neg) - mref; _Pragma("unroll") for (int i_ = 0; i_ < 16; ++i_) cin_[i_] = c_; } \
        _Pragma("unroll") for (int s_ = 0; s_ < 4; ++s_) { const int co_ = ((mp * 8 + 2 * s_ + hh) ^ kx) * 16; \
            const bf16x8 ka_ = *(const ATT_LAS bf16x8*)(kp_ + co_), kb_ = *(const ATT_LAS bf16x8*)(kp_ + 8192 + co_); \
            if (s_ == 0) { P0 = ATT_MFMA(ka_, qf[0], cin_); P1 = ATT_MFMA(kb_, qf[0], cin_); } else { P0 = ATT_MFMA(ka_, qf[s_], P0); P1 = ATT_MFMA(kb_, qf[s_], P1); } } } while (0)
#define ATT_NEARFIX(P0, P1, t) do { if (ATT_SIDE(t) == 1) { const int rb_ = (t) * 64 - (q0 + r) + 256 + 4 * hh; \
            _Pragma("unroll") for (int i_ = 0; i_ < 16; ++i_) { const int k_ = rb_ + (i_ & 3) + 8 * (i_ >> 2); P0[i_] += tb[k_] - bias_neg; P1[i_] += tb[k_ + 32] - bias_neg; } } } while (0)
#define ATT_SB() __builtin_amdgcn_sched_barrier(0)
#define ATT_KRD(s_, half_) (*(const ATT_LAS bf16x8*)(kp_ + (half_) * 8192 + ((mp * 8 + 2 * (s_) + hh) ^ kx) * 16))
#define ATT_VRD(DST, j_) do { const s16x4 lo_ = vtr(vp_ + (2 * ((j_) >> 2)) * 2048 + ((j_) & 3) * 512), hi_ = vtr(vp_ + (2 * ((j_) >> 2) + 1) * 2048 + ((j_) & 3) * 512); \
        DST = (bf16x8){lo_[0], lo_[1], lo_[2], lo_[3], hi_[0], hi_[1], hi_[2], hi_[3]}; } while (0)
#define ATT_EXP8(P, i0) do { _Pragma("unroll") for (int i_ = (i0); i_ < (i0) + 8; ++i_) P[i_] = __builtin_amdgcn_exp2f(P[i_]); } while (0)
#define ATT_PACK(DST, P, i0) do { u32x4 wv_; _Pragma("unroll") for (int j_ = 0; j_ < 4; ++j_) wv_[j_] = cvtpk(P[(i0) + 2 * j_], P[(i0) + 2 * j_ + 1]); DST = __builtin_bit_cast(bf16x8, wv_); } while (0)
#define ATT_SUM8(P, i0) do { _Pragma("unroll") for (int i_ = (i0); i_ < (i0) + 8; ++i_) l += P[i_]; } while (0)
#define ATT_KPRE(tq) do { const ldsp kp_ = lds + ((tq) & 3) * 16384 + kbase; ka0_ = ATT_KRD(0, 0); kb0_ = ATT_KRD(0, 1); ka1_ = ATT_KRD(1, 0); kb1_ = ATT_KRD(1, 1); } while (0)
#define ATT_QKEXP(PC0, PC1, PN0, PN1, tq, tv, KPRE) do { \
        const ldsp kp_ = lds + ((tq) & 3) * 16384 + kbase; const ldsp vp_ = lds + ((tv) & 3) * 16384 + vbase; \
        const bool near_ = ATT_SIDE(tq) == 1;                      \
        if (!near_) { const float c_ = (ATT_SIDE(tq) == 2 ? bias_pos : bias_neg) - mref; if (__any(c_ != ccur_)) { ccur_ = c_; _Pragma("unroll") for (int i_ = 0; i_ < 16; ++i_) cin_[i_] = c_; } } \
        if (!(KPRE)) { ka0_ = ATT_KRD(0, 0); kb0_ = ATT_KRD(0, 1); ka1_ = ATT_KRD(1, 0); kb1_ = ATT_KRD(1, 1); } \
        ATT_SB(); \
        ATT_EXP8(PC0, 0); \
        ATT_SB(); \
        if (near_) { const int rb_ = (tq) * 64 - (q0 + r) + 256 + 4 * hh; \
            _Pragma("unroll") for (int i_ = 0; i_ < 16; ++i_) { const int k_ = rb_ + (i_ & 3) + 8 * (i_ >> 2); PN0[i_] = tb[k_] - mref; PN1[i_] = tb[k_ + 32] - mref; } \
            PN0 = ATT_MFMA(ka0_, qf[0], PN0); PN1 = ATT_MFMA(kb0_, qf[0], PN1); } \
        else { PN0 = ATT_MFMA(ka0_, qf[0], cin_); PN1 = ATT_MFMA(kb0_, qf[0], cin_); } \
        ka0_ = ATT_KRD(2, 0); kb0_ = ATT_KRD(2, 1); ATT_EXP8(PC0, 8); \
        ATT_SB(); \
        PN0 = ATT_MFMA(ka1_, qf[1], PN0); PN1 = ATT_MFMA(kb1_, qf[1], PN1); ka1_ = ATT_KRD(3, 0); kb1_ = ATT_KRD(3, 1); ATT_EXP8(PC1, 0); \
        ATT_SB(); \
        PN0 = ATT_MFMA(ka0_, qf[2], PN0); PN1 = ATT_MFMA(kb0_, qf[2], PN1); ATT_VRD(vf0_, 0); ATT_VRD(vf1_, 1); ATT_EXP8(PC1, 8); \
        ATT_SB(); \
        PN0 = ATT_MFMA(ka1_, qf[3], PN0); PN1 = ATT_MFMA(kb1_, qf[3], PN1); ATT_VRD(vf2_, 2); ATT_VRD(vf3_, 3); ATT_PACK(pk0_, PC0, 0); ATT_SUM8(PC0, 0); \
        ATT_SB(); } while (0)
#define ATT_PV4(g_, PKCUR, NEXTWORK) do { \
        o[0] = ATT_MFMA(vf0_, PKCUR, o[0]); if ((g_) < 3) ATT_VRD(vf0_, 4 * (g_) + 4); NEXTWORK; ATT_SB(); \
        o[1] = ATT_MFMA(vf1_, PKCUR, o[1]); if ((g_) < 3) ATT_VRD(vf1_, 4 * (g_) + 5); ATT_SB(); \
        o[2] = ATT_MFMA(vf2_, PKCUR, o[2]); if ((g_) < 3) ATT_VRD(vf2_, 4 * (g_) + 6); ATT_SB(); \
        o[3] = ATT_MFMA(vf3_, PKCUR, o[3]); if ((g_) < 3) ATT_VRD(vf3_, 4 * (g_) + 7); ATT_SB(); } while (0)
#define ATT_PVBLOCK(PC0, PC1, tv, RMWORK, TAILWORK) do { const ldsp vp_ = lds + ((tv) & 3) * 16384 + vbase; bf16x8 pk1_; __builtin_amdgcn_s_setprio(1); \
        ATT_PV4(0, pk0_, do { ATT_PACK(pk1_, PC0, 8); ATT_SUM8(PC0, 8); } while (0)); \
        ATT_PV4(1, pk1_, do { ATT_PACK(pk0_, PC1, 0); ATT_SUM8(PC1, 0); } while (0)); \
        ATT_PV4(2, pk0_, do { ATT_PACK(pk1_, PC1, 8); ATT_SUM8(PC1, 8); RMWORK; } while (0)); \
        ATT_PV4(3, pk1_, TAILWORK); __builtin_amdgcn_s_setprio(0); } while (0)
#define ATT_RESCALE(P0, P1) do { \
        if (__any(mt_ > ATT_THR)) { const float dl_ = mt_ > ATT_THR ? mt_ : 0.f; const float f_ = __builtin_amdgcn_exp2f(-dl_); mref += dl_; l *= f_; \
            _Pragma("unroll") for (int d_ = 0; d_ < 4; ++d_) _Pragma("unroll") for (int i_ = 0; i_ < 16; ++i_) o[d_][i_] *= f_; \
            _Pragma("unroll") for (int i_ = 0; i_ < 16; ++i_) { P0[i_] -= dl_; P1[i_] -= dl_; } } } while (0)
#define ATT_DMA(t) do { if ((t) + 2 < NTILE) ATT_ISSUE_V(pbat, (t) + 2); if ((t) + 4 < NTILE) ATT_ISSUE_K(pbat, (t) + 4); } while (0)
#define ATT_CLOSE(t) do { if ((t) + 4 < NTILE) ATT_WAIT_BAR(6); else if ((t) + 4 == NTILE) ATT_WAIT_BAR(4); else if ((t) + 3 == NTILE) ATT_WAIT_BAR(2); else ATT_WAIT_BAR(0); } while (0)
#define ATT_STEP_L(PC0, PC1, PN0, PN1, t) do { float mt_ = 0.f; \
        ATT_DMA(t); \
        ATT_QKEXP(PC0, PC1, PN0, PN1, (t) + 1, t, false); \
        ATT_PVBLOCK(PC0, PC1, t, mt_ = rowmax32(PN0, PN1), (void)0); \
        if ((t) + 1 < NTILE) ATT_RESCALE(PN0, PN1); \
        ATT_CLOSE(t); } while (0)
#define ATT_STEP_T(PP0, PP1, PC0, PC1, t) do { float mt_ = 0.f; \
        if ((t) > 0) { ATT_PVBLOCK(PP0, PP1, (t) - 1, mt_ = rowmax32(PC0, PC1), ATT_KPRE((t) + 1)); ATT_RESCALE(PC0, PC1); } else ATT_KPRE((t) + 1); \
        ATT_DMA(t);                                                \
        ATT_QKEXP(PC0, PC1, PP0, PP1, (t) + 1, t, true);          \
        ATT_CLOSE(t); } while (0)
    bf16x8 qf[4];
    {
        ATT_LANE_SETUP();
        (void)ksrc; (void)vsrc;
        const bf16_t* qp = proj + ((size_t)((i_lo * 16 + xg) >> 2) * SEQ + q0 + r) * DIN + C_AQ + h * 128 + mp * 64 + hh * 8;
#pragma unroll
        for (int s = 0; s < 4; ++s) qf[s] = *(const bf16x8*)(qp + 16 * s);
    }
    for (int it = i_lo; it < i_hi; ++it) {
        ATT_LANE_SETUP();
        const int b = (it * 16 + xg) >> 2;
        const size_t tok0 = (size_t)b * SEQ;
        const bf16_t* pbat = proj + tok0 * DIN;
        const ATT_LAS float* tb = (const ATT_LAS float*)(lds + TBO);
        const int kbase = KR + r * 256, kx = r & 15;
        const int vbase = VR + (4 * hh + ((lane & 15) >> 2)) * 64 + ((lane >> 4) & 1) * 32 + (lane & 3) * 8;
        asm volatile("s_waitcnt lgkmcnt(0)\n\ts_barrier" ::: "memory");
        ATT_ISSUE_K(pbat, 2); ATT_ISSUE_K(pbat, 3);
        if (mp == 0 && it > i_lo) ATT_WAIT_BAR(12); else ATT_WAIT_BAR(10);
        const float bias_neg = tb[0], bias_pos = tb[511];
        f32x16 o[4];
#pragma unroll
        for (int d = 0; d < 4; ++d)
#pragma unroll
            for (int i = 0; i < 16; ++i) o[d][i] = 0.f;
        float mref = 0.f, l = 0.f;
        f32x16 pA0, pA1, pB0, pB1;
        ATT_QK(pA0, pA1, 0); ATT_NEARFIX(pA0, pA1, 0);
        { const float m0 = rowmax32(pA0, pA1); mref = m0;
#pragma unroll
          for (int i = 0; i < 16; ++i) { pA0[i] -= m0; pA1[i] -= m0; } }
        asm volatile("s_waitcnt lgkmcnt(0)\n\ts_barrier" ::: "memory");
        bf16x8 vf0_, vf1_, vf2_, vf3_, pk0_, ka0_, kb0_, ka1_, kb1_;
        f32x16 cin_; float ccur_ = __builtin_nanf("");
        if constexpr (TRAIL == 0) {
            for (int t = 0; t < NTILE; t += 2) {
                ATT_STEP_L(pA0, pA1, pB0, pB1, t);
                ATT_STEP_L(pB0, pB1, pA0, pA1, t + 1);
            }
        } else {
            for (int t = 0; t < NTILE; t += 2) {
                ATT_STEP_T(pB0, pB1, pA0, pA1, t);
                ATT_STEP_T(pA0, pA1, pB0, pB1, t + 1);
            }
            { float mt_ = 0.f; (void)mt_; ATT_PVBLOCK(pB0, pB1, NTILE - 1, (void)0, (void)0); }
        }
        __builtin_amdgcn_s_setprio(0);
        if (it + 1 < i_hi) { const bf16_t* pbn = proj + (size_t)(((it + 1) * 16 + xg) >> 2) * SEQ * DIN; ATT_ISSUE_K(pbn, 0); ATT_ISSUE_V(pbn, 0); ATT_ISSUE_K(pbn, 1); ATT_ISSUE_V(pbn, 1); }
#define ATT_NEXT_Q() do { if (it + 1 < i_hi) { const bf16_t* qp_ = proj + ((size_t)(((it + 1) * 16 + xg) >> 2) * SEQ + q0 + r) * DIN + C_AQ + h * 128 + mp * 64 + hh * 8; \
            _Pragma("unroll") for (int s_ = 0; s_ < 4; ++s_) qf[s_] = *(const bf16x8*)(qp_ + 16 * s_); } } while (0)
        const size_t trow = tok0 + q0 + r;
        const float ltot = l + __shfl_xor(l, 32);
        const float inv = __builtin_amdgcn_rcpf(ltot);
        ATT_LAS float* xw = (ATT_LAS float*)(lds + (qs == 0 ? KR + 3 * 16384 : qs == 1 ? KR + 2 * 16384 : qs == 2 ? VR + 2 * 16384 : XB)) + lane;
        if (mp == 1) {
            const float sc1 = lam * inv;
#pragma unroll
            for (int d = 0; d < 4; ++d)
#pragma unroll
                for (int i = 0; i < 16; ++i) xw[(d * 16 + i) * 64] = o[d][i] * sc1;
            ATT_NEXT_Q();
            asm volatile("s_waitcnt lgkmcnt(0)\n\ts_barrier" ::: "memory");
        } else {
            u32x4 gr[8];
            { const bf16_t* gsrc0 = proj + (tok0 + q0) * DIN + C_AG + h * 128;
#pragma unroll
              for (int i = 0; i < 8; ++i) { const int e = lane + 64 * i; gr[i] = *(const u32x4*)(gsrc0 + (size_t)(e >> 4) * DIN + (e & 15) * 8); } }
            asm volatile("s_waitcnt lgkmcnt(0)\n\ts_barrier" ::: "memory");
            float ss = 0.f;
#pragma unroll
            for (int d = 0; d < 4; ++d) {
#pragma unroll
                for (int i = 0; i < 16; ++i) { const float v = o[d][i] * inv - xw[(d * 16 + i) * 64]; o[d][i] = v; ss += v * v; }
                asm volatile("" ::: "memory");
            }
            ss += __shfl_xor(ss, 32);
            int ly_ = layer; asm volatile("" : "+s"(ly_));
            const float rs = rsqrtf(ss * (1.f / 128.f) + EPS) * (ly_ == 0 ? 0.8f : 0.64449093f);
            typedef unsigned u32x2 __attribute__((ext_vector_type(2)));
            const ldsp tl = (ldsp)xw - lane * 4;
            bf16_t* odst = mixed + (tok0 + q0) * DMIX + h * 128;
#pragma unroll
            for (int i = 0; i < 8; ++i) { const int e = lane + 64 * i; const ldsp gd = tl + (e >> 4) * 264 + (e & 15) * 16; *(ATT_LAS u32x2*)gd = (u32x2){gr[i][0], gr[i][1]}; *(ATT_LAS u32x2*)(gd + 8) = (u32x2){gr[i][2], gr[i][3]}; }
            ATT_NEXT_Q();
            asm volatile("s_waitcnt lgkmcnt(0)" ::: "memory");
            const ldsp tr_ = tl + r * 264 + 8 * hh;
#pragma unroll
            for (int d = 0; d < 4; ++d)
#pragma unroll
                for (int g = 0; g < 4; ++g) {
                    const int dd = d * 32 + 8 * g;
                    const u32x2 gv = *(const ATT_LAS u32x2*)(tr_ + dd * 2);
                    const float4 sw = *(const float4*)(subln_w + dd + 4 * hh);
                    const float g0 = __uint_as_float(gv.x << 16), g1 = __uint_as_float(gv.x & 0xffff0000u), g2 = __uint_as_float(gv.y << 16), g3 = __uint_as_float(gv.y & 0xffff0000u);
                    u32x2 w; w.x = pk2(o[d][4 * g] * rs * sw.x * g0, o[d][4 * g + 1] * rs * sw.y * g1); w.y = pk2(o[d][4 * g + 2] * rs * sw.z * g2, o[d][4 * g + 3] * rs * sw.w * g3);
                    *(ATT_LAS u32x2*)(tr_ + dd * 2) = w;
                }
            asm volatile("s_waitcnt lgkmcnt(0)" ::: "memory");
#pragma unroll
            for (int i = 0; i < 8; ++i) { const int e = lane + 64 * i; const ldsp od = tl + (e >> 4) * 264 + (e & 15) * 16; const u32x2 a0 = *(const ATT_LAS u32x2*)od, a1 = *(const ATT_LAS u32x2*)(od + 8);
                *(u32x4*)(odst + (size_t)(e >> 4) * DMIX + (e & 15) * 8) = (u32x4){a0.x, a0.y, a1.x, a1.y}; }
        }
    }
    asm volatile("s_waitcnt vmcnt(0)" ::: "memory");
#undef ATT_ISSUE_K
#undef ATT_WAIT_BAR
#undef ATT_ISSUE_V
#undef ATT_LANE_SETUP
#undef ATT_SIDE
#undef ATT_QK
#undef ATT_NEARFIX
#undef ATT_STEP_L
#undef ATT_STEP_T
#undef ATT_QKEXP
#undef ATT_KPRE
#undef ATT_PVBLOCK
#undef ATT_RESCALE
#undef ATT_DMA
#undef ATT_CLOSE
#undef ATT_NEXT_Q
#undef ATT_SB
#undef ATT_KRD
#undef ATT_VRD
#undef ATT_EXP8
#undef ATT_PACK
#undef ATT_SUM8
#undef ATT_PV4
}
__device__ __forceinline__ void attn_phase(ldsp lds, int i_lo, int i_hi, const bf16_t* proj, const float* tbl2, const float* diff_lambda, int layer, const float* subln_w, bf16_t* mixed) {
    asm volatile("" : "+s"(layer));
    const float lamv = diff_lambda[0];
    const float lam = __builtin_bit_cast(float, __builtin_amdgcn_readfirstlane(__builtin_bit_cast(int, lamv)));
    const int bid = blockIdx.x, xcd = bid & 7, slot = bid >> 3;
    if (__builtin_amdgcn_readfirstlane((int)threadIdx.x >> 6) >= 4) attn_run<1>(lds, i_lo, i_hi, xcd * 2 + (slot >> 4), slot & 15, proj, tbl2, lam, layer, subln_w, mixed);
    else attn_run<0>(lds, i_lo, i_hi, xcd * 2 + (slot >> 4), slot & 15, proj, tbl2, lam, layer, subln_w, mixed);
}
}

namespace ret {
using att::ldsp; using att::bf16x8; using att::s16x4; using att::f32x16; using att::u32x4; using att::vtr; using att::cvtpk; using att::crow;
typedef unsigned u32x2 __attribute__((ext_vector_type(2)));
constexpr size_t WS_RST = 480 * MiB;

__device__ __forceinline__ void ret_state_item(ldsp lds, int item, const bf16_t* __restrict__ proj, const float* __restrict__ decay_logit, bf16_t* __restrict__ rst, unsigned* cnt, unsigned* pre) {
    int tid_ = threadIdx.x; asm volatile("" : "+v"(tid_));
    const int tid = tid_, lane = tid & 63, wid = __builtin_amdgcn_readfirstlane(tid >> 6), r = lane & 31, hh = lane >> 5;
    const int vhalf = item & 1, dir = (item >> 1) & 1, h = (item >> 2) & 3, b = item >> 4;
    const int dblk = wid & 1, vblk = (wid >> 1) & 1;
    const float lg2 = decay_logit[dir * 4 + h];
    const float cd = __builtin_amdgcn_exp2f(lg2 * 128.f);
    const size_t tok0 = (size_t)b * SEQ;
    constexpr int KT = 0, VT = 16384, STG = 32768;
    const int m0 = tid >> 3, c8 = tid & 7;
    const unsigned gk = (unsigned)((tok0 + m0) * DIN + C_BK + h * 64 + c8 * 8), gv = (unsigned)((tok0 + m0) * DIN + C_BV + h * 128 + vhalf * 64 + c8 * 8);
    const int ldst = ((m0 >> 3) * 2 + (c8 >> 2)) * 512 + (m0 & 7) * 64 + (c8 & 3) * 16;
    const float sc0 = 0.125f * __builtin_amdgcn_exp2f(lg2 * (float)(dir == 0 ? 127 - m0 : m0)), sc1 = 0.125f * __builtin_amdgcn_exp2f(lg2 * (float)(dir == 0 ? 63 - m0 : m0 + 64));
    u32x4 kA[2], vA[2], kB[2], vB[2];
#define RS_ISSUE(KR, VR, c) do { _Pragma("unroll") for (int i_ = 0; i_ < 2; ++i_) { const unsigned o_ = (unsigned)((c) * 128 + 64 * i_) * DIN; KR[i_] = *(const u32x4*)(proj + gk + o_); VR[i_] = *(const u32x4*)(proj + gv + o_); } } while (0)
#define RS_COMMIT(KR, VR, buf) do { _Pragma("unroll") for (int i_ = 0; i_ < 2; ++i_) { const float sc_ = i_ == 0 ? sc0 : sc1; u32x4 w_; \
            _Pragma("unroll") for (int j_ = 0; j_ < 4; ++j_) { const unsigned u_ = KR[i_][j_]; w_[j_] = cvtpk(__uint_as_float(u_ << 16) * sc_, __uint_as_float(u_ & 0xffff0000u) * sc_); } \
            *(ATT_LAS u32x4*)(lds + (buf) * STG + KT + ldst + i_ * 8192) = w_; *(ATT_LAS u32x4*)(lds + (buf) * STG + VT + ldst + i_ * 8192) = VR[i_]; } } while (0)
#define RS_CHUNK(i) (dir == 0 ? (i) : 15 - (i))
    f32x16 acc;
#pragma unroll
    for (int i = 0; i < 16; ++i) acc[i] = 0.f;
    const int trb = ((lane & 15) >> 2) * 64 + ((lane >> 4) & 1) * 32 + (lane & 3) * 8 + hh * 1024;
#define RS_STEP(i, KR, VR) do { const int c_ = RS_CHUNK(i), buf_ = (i) & 1; \
        if (wid < 4) { unsigned char* dst_ = (unsigned char*)(rst + ((((size_t)(b * 4 + h) * 16 + c_) * 2 + dir) * 128 + vhalf * 64 + vblk * 32 + r) * 64 + dblk * 32) + hh * 16; \
            _Pragma("unroll") for (int j_ = 0; j_ < 2; ++j_) {     \
                unsigned a0_ = cvtpk(acc[8 * j_], acc[8 * j_ + 1]), a1_ = cvtpk(acc[8 * j_ + 2], acc[8 * j_ + 3]), b0_ = cvtpk(acc[8 * j_ + 4], acc[8 * j_ + 5]), b1_ = cvtpk(acc[8 * j_ + 6], acc[8 * j_ + 7]); \
                { const auto r0_ = __builtin_amdgcn_permlane32_swap(a0_, b0_, false, false); a0_ = r0_[0]; b0_ = r0_[1]; const auto r1_ = __builtin_amdgcn_permlane32_swap(a1_, b1_, false, false); a1_ = r1_[0]; b1_ = r1_[1]; } \
                *(u32x4*)(dst_ + 32 * j_) = (u32x4){a0_, a1_, b0_, b1_}; } \
            _Pragma("unroll") for (int k_ = 0; k_ < 16; ++k_) acc[k_] *= cd; \
            const ldsp kp_ = lds + buf_ * STG + KT + dblk * 512 + trb, vp_ = lds + buf_ * STG + VT + vblk * 512 + trb; \
            _Pragma("unroll") for (int ks_ = 0; ks_ < 8; ++ks_) { \
                const s16x4 alo_ = vtr(kp_ + ks_ * 2048), ahi_ = vtr(kp_ + ks_ * 2048 + 256), blo_ = vtr(vp_ + ks_ * 2048), bhi_ = vtr(vp_ + ks_ * 2048 + 256); \
                const bf16x8 a_ = {alo_[0], alo_[1], alo_[2], alo_[3], ahi_[0], ahi_[1], ahi_[2], ahi_[3]}, bb_ = {blo_[0], blo_[1], blo_[2], blo_[3], bhi_[0], bhi_[1], bhi_[2], bhi_[3]}; \
                acc = ATT_MFMA(a_, bb_, acc); } } \
        if ((i) + 1 < 16) RS_COMMIT(KR, VR, buf_ ^ 1); \
        if ((i) + 3 < 16) RS_ISSUE(KR, VR, RS_CHUNK((i) + 3)); \
        __syncthreads(); } while (0)
    __syncthreads();
    RS_ISSUE(kA, vA, RS_CHUNK(0)); RS_ISSUE(kB, vB, RS_CHUNK(1));
    RS_COMMIT(kA, vA, 0);
    RS_ISSUE(kA, vA, RS_CHUNK(2));
    __syncthreads();
    for (int i = 0; i < 16; i += 2) {
        RS_STEP(i, kB, vB);
        RS_STEP(i + 1, kA, vA);
    }
#undef RS_ISSUE
#undef RS_COMMIT
#undef RS_CHUNK
#undef RS_STEP
    asm volatile("s_waitcnt vmcnt(0)" ::: "memory");
    __syncthreads();
    if (tid == 0) {
        if (pre) {
            if (__hip_atomic_fetch_add(pre + (item >> 2), 1u, __ATOMIC_RELAXED, __HIP_MEMORY_SCOPE_AGENT) == 3u) {
                __builtin_amdgcn_fence(__ATOMIC_RELEASE, "agent"); asm volatile("s_waitcnt vmcnt(0)" ::: "memory");
                __hip_atomic_fetch_add(cnt + (item >> 2), 4u, __ATOMIC_RELAXED, __HIP_MEMORY_SCOPE_AGENT); }
        } else { __builtin_amdgcn_fence(__ATOMIC_RELEASE, "agent"); asm volatile("s_waitcnt vmcnt(0)" ::: "memory"); __hip_atomic_fetch_add(cnt + (item >> 2), 1u, __ATOMIC_RELAXED, __HIP_MEMORY_SCOPE_AGENT); }
    }
}
__device__ __forceinline__ void ret_wait_states(const unsigned* cnt, int bh0, int bh_stride, int n) {
    if (threadIdx.x == 0) {
        for (int i = 0; i < n; ++i) { unsigned sp = 0; while (__hip_atomic_load(cnt + bh0 + i * bh_stride, __ATOMIC_RELAXED, __HIP_MEMORY_SCOPE_AGENT) < 4u && ++sp < (1u << 20)) __builtin_amdgcn_s_sleep(2); }
        __builtin_amdgcn_fence(__ATOMIC_ACQUIRE, "agent"); asm volatile("s_waitcnt vmcnt(0)" ::: "memory");
    }
    __syncthreads();
}

__device__ __forceinline__ void ret_out_run(ldsp lds, int first, int stride, int nitems, const bf16_t* __restrict__ proj, const float* __restrict__ decay_logit, const bf16_t* __restrict__ rst, bf16_t* __restrict__ mixed) {
    int tid_ = threadIdx.x; asm volatile("" : "+v"(tid_));
    const int tid = tid_, lane = tid & 63, wid = __builtin_amdgcn_readfirstlane(tid >> 6), r = lane & 31, hh = lane >> 5;
    const int vhalf = wid & 1, nblk = wid >> 1;
    constexpr int KT = 0, VT = 16384, SLOT = 49152, RT = 2 * SLOT, SS = RT + 32768;
    unsigned ksrc[2], vsrc[4], rsrc[4];
#pragma unroll
    for (int i = 0; i < 2; ++i) { const int row = 16 * wid + 8 * i + (lane >> 3), ch = (lane & 7) ^ ((row >> 1) & 7); ksrc[i] = (unsigned)(row * DIN + C_BK + ch * 8); }
#pragma unroll
    for (int i = 0; i < 4; ++i) { const int row = 16 * wid + 8 * (i >> 1) + ((lane >> 2) & 7), ch = 4 * (2 * (i & 1) + (lane >> 5)) + (lane & 3); vsrc[i] = (unsigned)(row * DIN + C_BV + ch * 8); }
#pragma unroll
    for (int i = 0; i < 4; ++i) { const int pc = 4 * wid + i, row = 8 * (pc & 15) + (lane >> 3), ch = (lane & 7) ^ ((row >> 1) & 7); rsrc[i] = (unsigned)((pc >> 4) * 8192 + row * 64 + ch * 8); }
#define RO_DMA_KV(it, slot) do { const int c_ = (it) & 15, h_ = ((it) >> 4) & 3, b_ = (it) >> 6; const bf16_t* base_ = proj + ((size_t)b_ * SEQ + (size_t)c_ * 128) * DIN; \
        _Pragma("unroll") for (int i_ = 0; i_ < 2; ++i_) dma16(base_, 2u * (ksrc[i_] + (unsigned)h_ * 64u), (unsigned)(size_t)(lds + (slot) * SLOT + KT + wid * 2048 + i_ * 1024)); \
        _Pragma("unroll") for (int i_ = 0; i_ < 4; ++i_) dma16(base_, 2u * (vsrc[i_] + (unsigned)h_ * 128u), (unsigned)(size_t)(lds + (slot) * SLOT + VT + wid * 4096 + i_ * 1024)); } while (0)
#define RO_DMA_R(it) do { const bf16_t* base_ = rst + (size_t)((((it) >> 6) * 4 + (((it) >> 4) & 3)) * 16 + ((it) & 15)) * 2 * 8192; \
        _Pragma("unroll") for (int i_ = 0; i_ < 4; ++i_) dma16(base_, 2u * rsrc[i_], (unsigned)(size_t)(lds + RT + wid * 4096 + i_ * 1024)); } while (0)
#define RO_LOADQ(QF, it) do { const bf16_t* qp_ = proj + ((size_t)((it) >> 6) * SEQ + (size_t)((it) & 15) * 128 + nblk * 32 + r) * DIN + C_BQ + (((it) >> 4) & 3) * 64 + hh * 8; \
        _Pragma("unroll") for (int s_ = 0; s_ < 4; ++s_) QF[s_] = *(const bf16x8*)(qp_ + 16 * s_); } while (0)
    bf16x8 qn[4];
    __syncthreads();
    if (first < nitems) { RO_LOADQ(qn, first); RO_DMA_KV(first, 0); }
    asm volatile("s_waitcnt vmcnt(0)" ::: "memory");
    int slot = 0;
    for (int item = first; item < nitems; item += stride, slot ^= 1) {
        const int c = item & 15, h = (item >> 4) & 3, b = item >> 6;
        const float lgf = decay_logit[h], lgb = decay_logit[4 + h];
        const size_t tok0 = (size_t)b * SEQ + (size_t)c * 128;
        const int n = nblk * 32 + r;
        bf16x8 qf[4];
#pragma unroll
        for (int s = 0; s < 4; ++s) qf[s] = qn[s];
        asm volatile("s_waitcnt vmcnt(4) lgkmcnt(0)\n\ts_barrier" ::: "memory");
        RO_DMA_R(item);
        u32x4 gq[4];
        { const bf16_t* gp_ = proj + (tok0 + nblk * 32) * DIN + C_BG + h * 128 + vhalf * 64;
#pragma unroll
          for (int j = 0; j < 4; ++j) { const int e = lane + 64 * j; gq[j] = *(const u32x4*)(gp_ + (size_t)(e >> 3) * DIN + (e & 7) * 8); } }
        const bool has_next = item + stride < nitems;
        const ldsp kt = lds + slot * SLOT + KT, vt = lds + slot * SLOT + VT;
        f32x16 oi[2], of[2], ob[2];
#pragma unroll
        for (int v = 0; v < 2; ++v)
#pragma unroll
            for (int i = 0; i < 16; ++i) { oi[v][i] = 0.f; of[v][i] = 0.f; ob[v][i] = 0.f; }
        const int vbase = (4 * hh + ((lane & 15) >> 2)) * 64 + ((lane >> 4) & 1) * 32 + (lane & 3) * 8;
#pragma unroll
        for (int mb = 0; mb < 4; ++mb) {
            f32x16 p;
#pragma unroll
            for (int i = 0; i < 16; ++i) p[i] = 0.f;
            { const int m = mb * 32 + r; const int kb = m * 128, kx = (m >> 1) & 7;
#pragma unroll
              for (int s = 0; s < 4; ++s) { const bf16x8 ka = *(const ATT_LAS bf16x8*)(kt + kb + (((2 * s + hh) ^ kx) * 16)); p = ATT_MFMA(ka, qf[s], p); } }
#pragma unroll
            for (int i = 0; i < 16; ++i) {
                const int m = mb * 32 + crow(i, hh); const float dl = (float)(n - m);
                p[i] *= __builtin_amdgcn_exp2f(dl * (n >= m ? lgf : -lgb) - 3.f);
            }
#pragma unroll
            for (int s = 0; s < 2; ++s) {
                u32x4 wv;
#pragma unroll
                for (int j = 0; j < 4; ++j) wv[j] = cvtpk(p[8 * s + 2 * j], p[8 * s + 2 * j + 1]);
                const bf16x8 pb = __builtin_bit_cast(bf16x8, wv);
#pragma unroll
                for (int vb = 0; vb < 2; ++vb) {
                    const ldsp vp = vt + vbase + (vhalf * 2 + vb) * 512 + (4 * mb + 2 * s) * 2048;
                    const s16x4 lo = vtr(vp), hi = vtr(vp + 2048);
                    const bf16x8 va = {lo[0], lo[1], lo[2], lo[3], hi[0], hi[1], hi[2], hi[3]};
                    oi[vb] = ATT_MFMA(va, pb, oi[vb]);
                }
            }
            if (mb == 0 && has_next) RO_DMA_KV(item + stride, slot ^ 1);
        }
        if (has_next) asm volatile("s_waitcnt vmcnt(6) lgkmcnt(0)\n\ts_barrier" ::: "memory"); else asm volatile("s_waitcnt vmcnt(0) lgkmcnt(0)\n\ts_barrier" ::: "memory");
        const ldsp stg = lds + slot * SLOT + wid * 4352;
#pragma unroll
        for (int j = 0; j < 4; ++j) { const int e = lane + 64 * j; const ldsp gd = stg + (e >> 3) * 136 + (e & 7) * 16; *(ATT_LAS u32x2*)gd = (u32x2){gq[j][0], gq[j][1]}; *(ATT_LAS u32x2*)(gd + 8) = (u32x2){gq[j][2], gq[j][3]}; }
#pragma unroll
        for (int vb = 0; vb < 2; ++vb) {
            const int v = vhalf * 64 + vb * 32 + r; const int rbase = RT + v * 128, rx = (v >> 1) & 7;
#pragma unroll
            for (int s = 0; s < 4; ++s) {
                const int co = ((2 * s + hh) ^ rx) * 16;
                const bf16x8 af = *(const ATT_LAS bf16x8*)(lds + rbase + co), ab = *(const ATT_LAS bf16x8*)(lds + rbase + 16384 + co);
                of[vb] = ATT_MFMA(af, qf[s], of[vb]); ob[vb] = ATT_MFMA(ab, qf[s], ob[vb]);
            }
        }
        const float qdf = __builtin_amdgcn_exp2f(lgf * (float)(n + 1)), qdb = __builtin_amdgcn_exp2f(lgb * (float)(128 - n));
        float ss = 0.f;
#pragma unroll
        for (int vb = 0; vb < 2; ++vb)
#pragma unroll
            for (int i = 0; i < 16; ++i) { const float v = oi[vb][i] + qdf * of[vb][i] + qdb * ob[vb][i]; oi[vb][i] = v; ss += v * v; }
        ss += __shfl_xor(ss, 32);
        ATT_LAS float* sx = (ATT_LAS float*)(lds + SS + (slot & 1) * 1024);
        if (hh == 0) sx[wid * 32 + r] = ss;
        asm volatile("s_waitcnt lgkmcnt(0)\n\ts_barrier" ::: "memory");
        const float tot = sx[wid * 32 + r] + sx[(wid ^ 1) * 32 + r];
        const float rs = rsqrtf(tot * (1.f / 128.f) + EPS);
        const size_t trow = tok0 + n;
        if (has_next) RO_LOADQ(qn, item + stride);
        { const ldsp tr_ = stg + r * 136 + 8 * hh;
#pragma unroll
          for (int vb = 0; vb < 2; ++vb)
#pragma unroll
              for (int g = 0; g < 4; ++g) {
                  const int dd = vb * 32 + 8 * g;
                  const u32x2 gv = *(const ATT_LAS u32x2*)(tr_ + dd * 2);
                  const float g0 = __uint_as_float(gv.x << 16), g1 = __uint_as_float(gv.x & 0xffff0000u), g2 = __uint_as_float(gv.y << 16), g3 = __uint_as_float(gv.y & 0xffff0000u);
                  u32x2 w; w.x = pk2(oi[vb][4 * g] * rs * g0, oi[vb][4 * g + 1] * rs * g1); w.y = pk2(oi[vb][4 * g + 2] * rs * g2, oi[vb][4 * g + 3] * rs * g3);
                  *(ATT_LAS u32x2*)(tr_ + dd * 2) = w;
              }
          asm volatile("s_waitcnt lgkmcnt(0)" ::: "memory");
          bf16_t* ob_ = mixed + (tok0 + nblk * 32) * DMIX + 512 + h * 128 + vhalf * 64;
#pragma unroll
          for (int j = 0; j < 4; ++j) { const int e = lane + 64 * j; const ldsp od = stg + (e >> 3) * 136 + (e & 7) * 16; const u32x2 a0 = *(const ATT_LAS u32x2*)od, a1 = *(const ATT_LAS u32x2*)(od + 8);
              *(u32x4*)(ob_ + (size_t)(e >> 3) * DMIX + (e & 7) * 8) = (u32x4){a0.x, a0.y, a1.x, a1.y}; } }
    }
#undef RO_DMA_KV
#undef RO_DMA_R
#undef RO_LOADQ
}
}

namespace pool {
using att::ldsp; using att::bf16x8; using att::f32x16; using att::u32x4; using att::cvtpk; using att::crow;
typedef unsigned u32x2 __attribute__((ext_vector_type(2)));
constexpr size_t WS_PW = 28 * MiB;
__device__ __forceinline__ void pool_item(ldsp lds, int item, const bf16_t* __restrict__ proj, const bf16_t* __restrict__ pwT, const float* __restrict__ pool_scale, bf16_t* __restrict__ mixed) {
    int tid_ = threadIdx.x; asm volatile("" : "+v"(tid_));
    const int tid = tid_, lane = tid & 63, wid = __builtin_amdgcn_readfirstlane(tid >> 6), r = lane & 31, hh = lane >> 5;
    const int tokblk = wid >> 1, dhalf = wid & 1;
    const int t0 = item * 128, pos0 = t0 & (SEQ - 1);
    constexpr int RAW = 0, PL = 36864, GT = 69632, OT = 103424, RS = 264;
    u32x4 rreg[5];
#define PL_ISSUE(g) do { _Pragma("unroll") for (int i_ = 0; i_ < 5; ++i_) { const int e_ = tid + 512 * i_, row_ = e_ >> 4, pos_ = pos0 - 8 + row_; rreg[i_] = (u32x4){0u, 0u, 0u, 0u}; \
            if (e_ < 2304 && pos_ >= 0 && pos_ < SEQ) rreg[i_] = *(const u32x4*)(proj + (size_t)(t0 - 8 + row_) * DIN + C_CU + (g) * 128 + (e_ & 15) * 8); } } while (0)
#define PL_COMMIT() do { _Pragma("unroll") for (int i_ = 0; i_ < 5; ++i_) { const int e_ = tid + 512 * i_; if (e_ < 2304) *(ATT_LAS u32x4*)(lds + RAW + e_ * 16) = rreg[i_]; } } while (0)
#define PL_STORE(gq) do { _Pragma("unroll") for (int i_ = 0; i_ < 4; ++i_) { const int e_ = tid + 512 * i_; const ldsp od_ = lds + OT + (e_ >> 4) * RS + (e_ & 15) * 16; \
            const u32x2 a0_ = *(const ATT_LAS u32x2*)od_, a1_ = *(const ATT_LAS u32x2*)(od_ + 8); \
            *(u32x4*)(mixed + (size_t)(t0 + (e_ >> 4)) * DMIX + 1024 + (gq) * 128 + (e_ & 15) * 8) = (u32x4){a0_.x, a0_.y, a1_.x, a1_.y}; } } while (0)
    const int tok = tokblk * 32 + r;
    const size_t trow = (size_t)t0 + tok;
    __syncthreads();
    bf16x8 af[2][8]; float4 scv[2][4]; u32x4 greg[4];
#define PL_LOAD_AF(g) do { const bf16_t* wg_ = pwT + (size_t)(g) * 128 * 128 + (size_t)(dhalf * 2) * 4096 + lane * 8; \
        _Pragma("unroll") for (int db_ = 0; db_ < 2; ++db_) _Pragma("unroll") for (int ks_ = 0; ks_ < 8; ++ks_) af[db_][ks_] = *(const bf16x8*)(wg_ + db_ * 4096 + ks_ * 512); } while (0)
#define PL_LOAD_SC(g) do { const float* psc_ = pool_scale + (g) * 128 + dhalf * 64 + 4 * hh; \
        _Pragma("unroll") for (int db_ = 0; db_ < 2; ++db_) _Pragma("unroll") for (int q_ = 0; q_ < 4; ++q_) scv[db_][q_] = *(const float4*)(psc_ + db_ * 32 + 8 * q_); } while (0)
#define PL_LOAD_G(g) do { _Pragma("unroll") for (int i_ = 0; i_ < 4; ++i_) { const int e_ = tid + 512 * i_; greg[i_] = *(const u32x4*)(proj + (size_t)(t0 + (e_ >> 4)) * DIN + C_CG + (g) * 128 + (e_ & 15) * 8); } } while (0)
    PL_ISSUE(0);
    PL_COMMIT();
    PL_LOAD_AF(0);
    for (int g = 0; g < 4; ++g) {
        const int w2 = 1 << g;
        __syncthreads();
        PL_LOAD_SC(g); PL_LOAD_G(g);
        if (g + 1 < 4) PL_ISSUE(g + 1);
        {
            const int cc = tid & 15, tb = (tid >> 4) * 4;
            const ATT_LAS u32x4* raw = (const ATT_LAS u32x4*)(lds + RAW) + cc;
            float s[8];
#pragma unroll
            for (int j = 0; j < 8; ++j) s[j] = 0.f;
#define PL_ACC(SGN, row) do { const u32x4 v_ = raw[(row) * 16]; _Pragma("unroll") for (int j_ = 0; j_ < 4; ++j_) { s[2 * j_] += SGN __uint_as_float(v_[j_] << 16); s[2 * j_ + 1] += SGN __uint_as_float(v_[j_] & 0xffff0000u); } } while (0)
            for (int p = tb - w2; p < tb + w2; ++p) PL_ACC(+, p + 8);
#pragma unroll
            for (int tt = 0; tt < 4; ++tt) {
                const int t = tb + tt, pos = pos0 + t;
                int lo = pos - w2; if (lo < 0) lo = 0; int hi = pos + w2; if (hi > SEQ) hi = SEQ;
                const float inv = 1.f / (float)(hi - lo);
                const u32x4 cur = raw[(t + 8) * 16]; u32x4 w;
#pragma unroll
                for (int j = 0; j < 4; ++j) w[j] = cvtpk(s[2 * j] * inv - __uint_as_float(cur[j] << 16), s[2 * j + 1] * inv - __uint_as_float(cur[j] & 0xffff0000u));
                *(ATT_LAS u32x4*)(lds + PL + t * 256 + ((cc ^ (t & 15)) * 16)) = w;
                if (tt < 3) { PL_ACC(+, t + w2 + 8); PL_ACC(-, t - w2 + 8); }
            }
#undef PL_ACC
        }
        __syncthreads();
        if (g > 0) PL_STORE(g - 1);
        if (g + 1 < 4) PL_COMMIT();
#pragma unroll
        for (int i = 0; i < 4; ++i) { const int e = tid + 512 * i; const ldsp gd = lds + GT + (e >> 4) * RS + (e & 15) * 16; *(ATT_LAS u32x2*)gd = (u32x2){greg[i][0], greg[i][1]}; *(ATT_LAS u32x2*)(gd + 8) = (u32x2){greg[i][2], greg[i][3]}; }
        f32x16 acc[2];
#pragma unroll
        for (int db = 0; db < 2; ++db)
#pragma unroll
            for (int i = 0; i < 16; ++i) acc[db][i] = 0.f;
#pragma unroll
        for (int ks = 0; ks < 8; ++ks) {
            const bf16x8 bfrag = *(const ATT_LAS bf16x8*)(lds + PL + tok * 256 + (((2 * ks + hh) ^ (tok & 15)) * 16));
#pragma unroll
            for (int db = 0; db < 2; ++db) acc[db] = ATT_MFMA(af[db][ks], bfrag, acc[db]);
        }
        asm volatile("s_waitcnt lgkmcnt(0)\n\ts_barrier" ::: "memory");
        if (g + 1 < 4) PL_LOAD_AF(g + 1);
        {
            const ldsp gl = lds + GT + tok * RS + (dhalf * 64 + 4 * hh) * 2, ol = lds + OT + tok * RS + (dhalf * 64 + 4 * hh) * 2;
#pragma unroll
            for (int db = 0; db < 2; ++db)
#pragma unroll
                for (int q = 0; q < 4; ++q) {
                    const u32x2 gq = *(const ATT_LAS u32x2*)(gl + (db * 32 + 8 * q) * 2); const float4 sc = scv[db][q];
                    const float g0 = __uint_as_float(gq.x << 16), g1 = __uint_as_float(gq.x & 0xffff0000u), g2 = __uint_as_float(gq.y << 16), g3 = __uint_as_float(gq.y & 0xffff0000u);
                    u32x2 w; w.x = pk2(acc[db][4 * q] * sc.x * g0, acc[db][4 * q + 1] * sc.y * g1); w.y = pk2(acc[db][4 * q + 2] * sc.z * g2, acc[db][4 * q + 3] * sc.w * g3);
                    *(ATT_LAS u32x2*)(ol + (db * 32 + 8 * q) * 2) = w;
                }
        }
    }
    __syncthreads();
    PL_STORE(3);
#undef PL_ISSUE
#undef PL_LOAD_AF
#undef PL_LOAD_SC
#undef PL_LOAD_G
#undef PL_STORE
#undef PL_COMMIT
}
}

__global__ void __launch_bounds__(NT, 2) mega(Params P) {
    extern __shared__ __attribute__((aligned(16))) unsigned char lds_raw[];
    float* lds = (float*)lds_raw;
    PG8_LAS unsigned char* lds3 = (PG8_LAS unsigned char*)lds_raw;
    cg::grid_group grid = cg::this_grid();
    unsigned char* ws = P.ws;
    float* biastbl = (float*)(ws + WS_BIAS);
    bf16_t* proj = (bf16_t*)(ws + WS_PROJ); bf16_t* mixed = (bf16_t*)(ws + WS_MIX); bf16_t* xb = (bf16_t*)(ws + WS_XB);
    volatile LAS unsigned* bst = (volatile LAS unsigned*)(lds3 + (LDS_BYTES - 64));
    if (threadIdx.x == 0) { bst[0] = 0u; bst[1] = 0u; }
    __syncthreads();
    const XcdBarrier bar = xcd_barrier_post((unsigned*)ws, bst);
    if (threadIdx.x == 0 && blockIdx.x < 8u) __hip_atomic_store((unsigned*)(ws + WS_XMIS) + blockIdx.x, bar.x + 1u, __ATOMIC_RELAXED, __HIP_MEMORY_SCOPE_AGENT);
    ph_prologue(P, lds);
    if (P.use_cg_sync) grid.sync();
    xcd_barrier(bar);
    if (threadIdx.x == 0 && __hip_atomic_load((const unsigned*)(ws + WS_XMIS) + (blockIdx.x & 7u), __ATOMIC_RELAXED, __HIP_MEMORY_SCOPE_AGENT) != bar.x + 1u)
        __hip_atomic_fetch_add((unsigned*)(ws + WS_XMIS) + 8, 1u, __ATOMIC_RELAXED, __HIP_MEMORY_SCOPE_AGENT);
    for (int l = 0; l < 2; ++l) {
        {
            pg8::Gemm g{xb, (const bf16_t*)(ws + WS_WIN) + (size_t)l * DIN * DM, T, DIN, DM};
            pg8::StaticOrder S; S.init(T, DIN, (int)gridDim.x, (int)blockIdx.x, WGM_P1);
            EpiProj E{proj, (const float*)(ws + (l == 0 ? WS_RSS0 : WS_RSS1)), (const float2*)(ws + WS_ROT), lds3 + 131072 + 8192};
            pg8::gemm_phase<EpiProj, pg8::StaticOrder, true, true>(lds3, g, S, E);
        }
        xcd_barrier(bar);
        {
            unsigned* cst = (unsigned*)(ws + WS_CNT) + l * 64;
            const att::ldsp ldsa = (att::ldsp)lds_raw;
            const int bid = (int)blockIdx.x, G = (int)gridDim.x;
            const bool grouped = G == 256 && __builtin_amdgcn_readfirstlane((int)__hip_atomic_load((const unsigned*)(ws + WS_XMIS) + 8, __ATOMIC_RELAXED, __HIP_MEMORY_SCOPE_AGENT)) == 0;
            for (int it = (grouped ? ((((bid & 7) * 8 + (bid >> 5)) << 2) | ((bid >> 3) & 3)) : bid); it < 256; it += G)
                ret::ret_state_item(ldsa, it, proj, (const float*)(ws + WS_CONST) + l * 8, (bf16_t*)(ws + ret::WS_RST), cst, grouped ? cst + 128 : (unsigned*)nullptr);
            const int rho = G == 256 ? ((bid & 7) * 2 + (bid >> 7)) % 5 : 4;
            att::attn_phase(ldsa, 0, rho, proj, biastbl, (const float*)(ws + WS_CONST) + 16 + l, l, P.subln + l * 128, mixed);
            __syncthreads();
            if (G == 256) ret::ret_wait_states(cst, bid >> 4 & 3 | (bid >> 6) << 2, 16, 4); else ret::ret_wait_states(cst, 0, 1, 64);
            ret::ret_out_run(ldsa, bid, G, 1024, proj, (const float*)(ws + WS_CONST) + l * 8, (const bf16_t*)(ws + ret::WS_RST), mixed);
            __syncthreads();
            for (int it = bid; it < 256; it += G) pool::pool_item(ldsa, it, proj, (const bf16_t*)(ws + pool::WS_PW) + (size_t)l * 4 * 128 * 128, P.pool_scale + l * 512, mixed);
            __syncthreads();
            att::attn_phase(ldsa, rho, 4, proj, biastbl, (const float*)(ws + WS_CONST) + 16 + l, l, P.subln + l * 128, mixed);
            __syncthreads();
        }
        xcd_barrier(bar);
        {
            pg8::Gemm g{mixed, (const bf16_t*)(ws + WS_WOUT) + (size_t)l * DM * DMIX, T, DM, DMIX};
            pg8::StaticOrder S; S.init(T, DM, (int)gridDim.x, (int)blockIdx.x);
            if (l == 0) { EpiOut<0> E{P.out, xb, (float*)(ws + WS_RSS1), lds3 + 131072 + 8192}; pg8::gemm_phase<EpiOut<0>, pg8::StaticOrder, true, true>(lds3, g, S, E); }
            else if (gridDim.x == 256) { EpiOutFinal E{P.out, xb, P.fnw, (float*)(ws + WS_SLOT), (unsigned*)(ws + WS_PCNT), lds3 + 131072, lds3 + 131072 + 8192}; pg8::gemm_phase<EpiOutFinal, pg8::StaticOrder, true, true>(lds3, g, S, E); }
            else { EpiOut<1> E{P.out, xb, (float*)(ws + WS_RSS1), lds3 + 131072 + 8192}; pg8::gemm_phase<EpiOut<1>, pg8::StaticOrder, true, true>(lds3, g, S, E); }
        }
        if (l == 0 || gridDim.x != 256) xcd_barrier(bar);
    }
    if (gridDim.x != 256) ph_final_norm(P.out, P.fnw);
}

extern "C" void kernel_launch(void* const* d_in, const int* in_sizes, int n_in, void* d_out, int out_size, void* d_ws, size_t ws_size, hipStream_t stream) {
    static int grid_blocks = 0;
    if (!grid_blocks) {
        int dev = 0, cus = 0, per_cu = 0;
        (void)hipGetDevice(&dev);
        (void)hipDeviceGetAttribute(&cus, hipDeviceAttributeMultiprocessorCount, dev);
        (void)hipFuncSetAttribute((const void*)mega, hipFuncAttributeMaxDynamicSharedMemorySize, LDS_BYTES);
        (void)hipOccupancyMaxActiveBlocksPerMultiprocessor(&per_cu, (const void*)mega, NT, LDS_BYTES);
        if (per_cu < 1) per_cu = 1;
        grid_blocks = 256;
        if (cus * per_cu < 256) fprintf(stderr, "kernel_launch: device capacity %d x %d < 256 workgroups: the cooperative launch will be rejected\n", cus, per_cu);
    }
    Params p{};
    p.x = (const float*)d_in[0]; p.norm_w = (const float*)d_in[1]; p.w_in = (const float*)d_in[2]; p.diff_lambda = (const float*)d_in[3];
    p.subln = (const float*)d_in[4]; p.decay = (const float*)d_in[5]; p.pool_w = (const float*)d_in[6]; p.pool_scale = (const float*)d_in[7];
    p.w_out = (const float*)d_in[8]; p.rel_bias = (const float*)d_in[9]; p.fnw = (const float*)d_in[10];
    p.out = (float*)d_out; p.ws = (unsigned char*)d_ws;
    (void)hipMemsetAsync(d_ws, 0, 65536, stream);
    void* args[] = {&p};
    hipError_t e = hipLaunchCooperativeKernel((const void*)mega, dim3(grid_blocks), dim3(NT), args, LDS_BYTES, stream);
    if (e != hipSuccess) fprintf(stderr, "cooperative launch failed: %s (grid %d)\n", hipGetErrorString(e), grid_blocks);
}
```
